# Optimizing an MI355X kernel written in HIP

```python
import math
import jax, jax.numpy as jnp
from jax import lax
import numpy as np

D_MODEL = 2048
BATCH = 4
SEQ = 2048
DEPTH = 2

GRID_W = 64
CTX_LEN = 256
N_MIXERS = 2
N_A_LAYERS = (DEPTH + 1) // 2
N_B_LAYERS = DEPTH // 2

S5_GROUP = 16
S5_GROUPS = D_MODEL // S5_GROUP
S5_STATE = 64
S5_DT_MIN = 1e-3
S5_DT_MAX = 1e-1

HEAD_DIM = 128
N_Q_HEADS = D_MODEL // HEAD_DIM
N_KV_HEADS = N_Q_HEADS // 4
KV_REP = N_Q_HEADS // N_KV_HEADS
Q_DIM = N_Q_HEADS * HEAD_DIM
KV_DIM = N_KV_HEADS * HEAD_DIM
Q_BLOCK = 128
ROPE_THETA = 10000.0
ROPE_PAIRS_PER_AXIS = HEAD_DIM // 4

D_FF = 5632
N_MOD = 9
EPS = 1e-6

kernel_name = "hybrid_s5_gqa_macaron_dit"


def rmsnorm(x, g):
    xf = x.astype(jnp.float32)
    r = lax.rsqrt(jnp.mean(xf * xf, axis=-1, keepdims=True) + EPS)
    return (xf * r * g.astype(jnp.float32)).astype(x.dtype)


def modulate(h, shift, scale):
    return h * (1.0 + scale) + shift


def swiglu(h, w_gate, w_up, w_down):
    return (jax.nn.silu(h @ w_gate) * (h @ w_up)) @ w_down


def s5_scan(u, a_re, a_im, log_dt, b_re, b_im, c_re, c_im, reverse):
    lam = lax.complex(a_re.astype(jnp.float32), a_im.astype(jnp.float32))
    dt = jnp.exp(log_dt.astype(jnp.float32))[:, None]
    lam_bar = jnp.exp(lam * dt)
    b = lax.complex(b_re.astype(jnp.float32), b_im.astype(jnp.float32))
    b_bar = ((lam_bar - 1.0) / lam)[..., None] * b
    bu = jnp.einsum('gph,btgh->btgp', b_bar, u.astype(jnp.complex64))
    a = jnp.broadcast_to(lam_bar, bu.shape)

    def combine(left, right):
        a_l, b_l = left
        a_r, b_r = right
        return a_r * a_l, a_r * b_l + b_r

    _, h = lax.associative_scan(combine, (a, bu), axis=1, reverse=reverse)
    cm = lax.complex(c_re.astype(jnp.float32), c_im.astype(jnp.float32))
    return jnp.einsum('ghp,btgp->btgh', cm, h).real


def s5_output(y, u, d_skip, w1, w2):
    y = y + d_skip.astype(jnp.float32) * u.astype(jnp.float32)
    z = jax.nn.gelu(y).astype(u.dtype)
    return (z @ w1) * jax.nn.sigmoid(z @ w2)


def s5_mixer(h_ctx, h_lat, a_re, a_im, log_dt, b_re, b_im, c_re, c_im, d_skip, w1, w2, need_ctx):
    B, S, D = h_lat.shape
    L = h_ctx.shape[1]
    u_ctx = h_ctx.astype(jnp.float32).reshape(B, L, S5_GROUPS, S5_GROUP)
    u_lat = h_lat.astype(jnp.float32).reshape(B, S, S5_GROUPS, S5_GROUP)
    y_f = s5_scan(jnp.concatenate([u_ctx, u_lat], axis=1), a_re[0], a_im[0], log_dt[0],
                  b_re[0], b_im[0], c_re[0], c_im[0], reverse=False)
    y_b = s5_scan(jnp.concatenate([u_lat, u_ctx], axis=1), a_re[1], a_im[1], log_dt[1],
                  b_re[1], b_im[1], c_re[1], c_im[1], reverse=True)
    y_lat = (y_f[:, L:] + y_b[:, :S]).reshape(B, S, D)
    out_lat = s5_output(y_lat, h_lat, d_skip, w1, w2)
    out_ctx = None
    if need_ctx:
        y_ctx = (y_f[:, :L] + y_b[:, S:]).reshape(B, L, D)
        out_ctx = s5_output(y_ctx, h_ctx, d_skip, w1, w2)
    return out_ctx, out_lat


def axial_rope_tables(pos_row, pos_col):
    freqs = ROPE_THETA ** (-jnp.arange(ROPE_PAIRS_PER_AXIS, dtype=jnp.float32) / ROPE_PAIRS_PER_AXIS)
    ang_r = pos_row.astype(jnp.float32)[:, None] * freqs
    ang_c = pos_col.astype(jnp.float32)[:, None] * freqs
    return jnp.cos(ang_r), jnp.sin(ang_r), jnp.cos(ang_c), jnp.sin(ang_c)


def rotate(x, cos, sin):
    x1, x2 = jnp.split(x, 2, axis=-1)
    c = cos[:, None, :].astype(x.dtype)
    s = sin[:, None, :].astype(x.dtype)
    return jnp.concatenate([x1 * c - x2 * s, x2 * c + x1 * s], axis=-1)


def apply_axial_rope(x, tabs):
    cos_r, sin_r, cos_c, sin_c = tabs
    half = HEAD_DIM // 2
    return jnp.concatenate([rotate(x[..., :half], cos_r, sin_r),
                            rotate(x[..., half:], cos_c, sin_c)], axis=-1)


def attend(q, k, v):
    s = jnp.einsum('bqgrd,bkgd->bgrqk', q, k).astype(jnp.float32) * (HEAD_DIM ** -0.5)
    p = jax.nn.softmax(s, axis=-1)
    return jnp.einsum('bgrqk,bkgd->bqgrd', p.astype(v.dtype), v)


def gqa_mixer(h_ctx, h_lat, w_qkv, w_o, q_gain, k_gain, rope_tabs, need_ctx):
    B, S, D = h_lat.shape
    L = h_ctx.shape[1]

    def project(h):
        T = h.shape[1]
        qkv = h @ w_qkv
        q = rmsnorm(qkv[..., :Q_DIM].reshape(B, T, N_Q_HEADS, HEAD_DIM), q_gain)
        k = rmsnorm(qkv[..., Q_DIM:Q_DIM + KV_DIM].reshape(B, T, N_KV_HEADS, HEAD_DIM), k_gain)
        v = qkv[..., Q_DIM + KV_DIM:].reshape(B, T, N_KV_HEADS, HEAD_DIM)
        return q, k, v

    q_c, k_c, v_c = project(h_ctx)
    q_l, k_l, v_l = project(h_lat)
    q_l = apply_axial_rope(q_l, rope_tabs)
    k_l = apply_axial_rope(k_l, rope_tabs)
    k_all = jnp.concatenate([k_c, k_l], axis=1)
    v_all = jnp.concatenate([v_c, v_l], axis=1)

    n_blk = S // Q_BLOCK
    q_blocks = q_l.reshape(B, n_blk, Q_BLOCK, N_KV_HEADS, KV_REP, HEAD_DIM).transpose(1, 0, 2, 3, 4, 5)
    o_l = lax.map(lambda qb: attend(qb, k_all, v_all), q_blocks)
    o_l = o_l.transpose(1, 0, 2, 3, 4, 5).reshape(B, S, Q_DIM)
    out_lat = o_l @ w_o
    out_ctx = None
    if need_ctx:
        o_c = attend(q_c.reshape(B, L, N_KV_HEADS, KV_REP, HEAD_DIM), k_c, v_c).reshape(B, L, Q_DIM)
        out_ctx = o_c @ w_o
    return out_ctx, out_lat


def setup_inputs(seed: int = 0) -> dict:
    key = jax.random.key(seed)
    ks = jax.random.split(key, 32)
    f32 = jnp.float32
    D, F, G, H, P = D_MODEL, D_FF, S5_GROUPS, S5_GROUP, S5_STATE

    def nrm(k, shape, scale):
        return jax.random.normal(k, shape, f32) * scale

    a_im_base = jnp.pi * jnp.arange(P, dtype=f32)
    return {
        "x": nrm(ks[0], (BATCH, SEQ, D), 1.0),
        "c": nrm(ks[1], (BATCH, D), 1.0),
        "ctx": nrm(ks[2], (BATCH, CTX_LEN, D), 1.0),
        "c_ctx": nrm(ks[3], (D,), 1.0),
        "ada_w": nrm(ks[4], (DEPTH, D, N_MOD * D), 0.5 * D ** -0.5),
        "ada_b": nrm(ks[5], (DEPTH, N_MOD * D), 0.02),
        "norm_ffn1": 1.0 + nrm(ks[6], (DEPTH, D), 0.02),
        "norm_mix": 1.0 + nrm(ks[7], (DEPTH, D), 0.02),
        "norm_ffn2": 1.0 + nrm(ks[8], (DEPTH, D), 0.02),
        "ffn1_w_gate": nrm(ks[9], (DEPTH, D, F), D ** -0.5),
        "ffn1_w_up": nrm(ks[10], (DEPTH, D, F), D ** -0.5),
        "ffn1_w_down": nrm(ks[11], (DEPTH, F, D), F ** -0.5),
        "ffn2_w_gate": nrm(ks[12], (DEPTH, D, F), D ** -0.5),
        "ffn2_w_up": nrm(ks[13], (DEPTH, D, F), D ** -0.5),
        "ffn2_w_down": nrm(ks[14], (DEPTH, F, D), F ** -0.5),
        "s5_a_re": -0.5 * jnp.exp(nrm(ks[15], (N_A_LAYERS, 2, G, P), 0.1)),
        "s5_a_im": a_im_base + nrm(ks[16], (N_A_LAYERS, 2, G, P), 0.01),
        "s5_log_dt": jax.random.uniform(ks[17], (N_A_LAYERS, 2, G), f32,
                                        math.log(S5_DT_MIN), math.log(S5_DT_MAX)),
        "s5_b_re": nrm(ks[18], (N_A_LAYERS, 2, G, P, H), (2 * H) ** -0.5),
        "s5_b_im": nrm(ks[19], (N_A_LAYERS, 2, G, P, H), (2 * H) ** -0.5),
        "s5_c_re": nrm(ks[20], (N_A_LAYERS, 2, G, H, P), P ** -0.5),
        "s5_c_im": nrm(ks[21], (N_A_LAYERS, 2, G, H, P), P ** -0.5),
        "s5_d": nrm(ks[22], (N_A_LAYERS, D), 1.0),
        "s5_glu_w1": nrm(ks[23], (N_A_LAYERS, D, D), D ** -0.5),
        "s5_glu_w2": nrm(ks[24], (N_A_LAYERS, D, D), D ** -0.5),
        "attn_w_qkv": nrm(ks[25], (N_B_LAYERS, D, Q_DIM + 2 * KV_DIM), D ** -0.5),
        "attn_w_o": nrm(ks[26], (N_B_LAYERS, Q_DIM, D), Q_DIM ** -0.5),
        "attn_q_gain": 1.0 + nrm(ks[27], (N_B_LAYERS, HEAD_DIM), 0.02),
        "attn_k_gain": 1.0 + nrm(ks[28], (N_B_LAYERS, HEAD_DIM), 0.02),
    }


def reference(x, c, ctx, c_ctx, ada_w, ada_b, norm_ffn1, norm_mix, norm_ffn2,
              ffn1_w_gate, ffn1_w_up, ffn1_w_down, ffn2_w_gate, ffn2_w_up, ffn2_w_down,
              s5_a_re, s5_a_im, s5_log_dt, s5_b_re, s5_b_im, s5_c_re, s5_c_im, s5_d,
              s5_glu_w1, s5_glu_w2, attn_w_qkv, attn_w_o, attn_q_gain, attn_k_gain):
    B, S, D = x.shape
    ROWS = S // GRID_W
    pos_row = jnp.repeat(jnp.arange(ROWS, dtype=jnp.int32), GRID_W)
    pos_col = jnp.tile(jnp.arange(GRID_W, dtype=jnp.int32), ROWS)
    rope_tabs = axial_rope_tables(pos_row, pos_col)

    silu_c = jax.nn.silu(c)
    silu_cc = jax.nn.silu(c_ctx)
    h_lat, h_ctx = x, ctx

    for i in range(DEPTH):
        last = i == DEPTH - 1
        mod_l = [m[:, None, :] for m in jnp.split(silu_c @ ada_w[i] + ada_b[i], N_MOD, axis=-1)]
        mod_c = [m[None, None, :] for m in jnp.split(silu_cc @ ada_w[i] + ada_b[i], N_MOD, axis=-1)]
        sh1, sc1, g1, shm, scm, gm, sh2, sc2, g2 = mod_l
        csh1, csc1, cg1, cshm, cscm, cgm, csh2, csc2, cg2 = mod_c

        w1 = (ffn1_w_gate[i], ffn1_w_up[i], ffn1_w_down[i])
        h_lat = h_lat + 0.5 * g1 * swiglu(modulate(rmsnorm(h_lat, norm_ffn1[i]), sh1, sc1), *w1)
        h_ctx = h_ctx + 0.5 * cg1 * swiglu(modulate(rmsnorm(h_ctx, norm_ffn1[i]), csh1, csc1), *w1)

        u_lat = modulate(rmsnorm(h_lat, norm_mix[i]), shm, scm)
        u_ctx = modulate(rmsnorm(h_ctx, norm_mix[i]), cshm, cscm)
        if i % N_MIXERS == 0:
            j = i // N_MIXERS
            o_ctx, o_lat = s5_mixer(u_ctx, u_lat, s5_a_re[j], s5_a_im[j], s5_log_dt[j],
                                    s5_b_re[j], s5_b_im[j], s5_c_re[j], s5_c_im[j], s5_d[j],
                                    s5_glu_w1[j], s5_glu_w2[j], need_ctx=not last)
        else:
            j = i // N_MIXERS
            o_ctx, o_lat = gqa_mixer(u_ctx, u_lat, attn_w_qkv[j], attn_w_o[j], attn_q_gain[j],
                                     attn_k_gain[j], rope_tabs, need_ctx=not last)
        h_lat = h_lat + gm * o_lat
        if not last:
            h_ctx = h_ctx + cgm * o_ctx

        w2 = (ffn2_w_gate[i], ffn2_w_up[i], ffn2_w_down[i])
        h_lat = h_lat + 0.5 * g2 * swiglu(modulate(rmsnorm(h_lat, norm_ffn2[i]), sh2, sc2), *w2)
        if not last:
            h_ctx = h_ctx + 0.5 * cg2 * swiglu(modulate(rmsnorm(h_ctx, norm_ffn2[i]), csh2, csc2), *w2)

    return h_lat
```

```cpp
#include <hip/hip_runtime.h>
#include <hip/hip_cooperative_groups.h>
#include <cstdio>
#include <cstdint>
namespace cg = cooperative_groups;

#ifndef MULTI_LAUNCH
#define MULTI_LAUNCH 0
#endif

typedef unsigned short bf16_t;
typedef short bf16x8 __attribute__((ext_vector_type(8)));
typedef short s16x4 __attribute__((ext_vector_type(4)));
typedef float f32x2 __attribute__((ext_vector_type(2)));
typedef float f32x4 __attribute__((ext_vector_type(4)));
typedef float f32x16 __attribute__((ext_vector_type(16)));
typedef unsigned u32x2 __attribute__((ext_vector_type(2)));
typedef unsigned u32x4 __attribute__((ext_vector_type(4)));
#define LAS __attribute__((address_space(3)))

constexpr int DM = 2048, NBATCH = 4, SEQ = 2048, CTXL = 256, DFF = 5632, NMODC = 9 * DM  ;
constexpr int MLAT = NBATCH * SEQ  , MCTX = NBATCH * CTXL  , MTOT = MLAT + MCTX  ;
constexpr int TKV = CTXL + SEQ  ;
constexpr int NQKV = 3072, KVD = 512;
constexpr int NPHASE = 22;
constexpr int LDS_BYTES = 131072;

constexpr size_t SZ_WGU = (size_t)2 * DFF * DM * 2, SZ_WD = (size_t)DM * DFF * 2;
constexpr size_t WS_WGU = 0;
constexpr size_t WS_WD = WS_WGU + 4 * SZ_WGU;
constexpr size_t WS_W12 = WS_WD + 4 * SZ_WD;
constexpr size_t WS_WQKV = WS_W12 + (size_t)4096 * DM * 2;
constexpr size_t WS_WO = WS_WQKV + (size_t)NQKV * DM * 2;
constexpr size_t WS_MOD = WS_WO + (size_t)DM * DM * 2;
constexpr size_t WS_H = WS_MOD + (size_t)2 * 5 * NMODC * 4;
constexpr size_t WS_A = WS_H + (size_t)MTOT * DM * 4;
constexpr size_t WS_HID = WS_A + (size_t)MTOT * DM * 2;
constexpr size_t WS_YF = WS_HID + (size_t)MTOT * DFF * 2;
constexpr size_t WS_YB = WS_YF + (size_t)MTOT * DM * 4;
constexpr size_t WS_Z = WS_YB + (size_t)MTOT * DM * 4;
constexpr size_t WS_QKV = WS_Z + (size_t)MTOT * DM * 2;
constexpr size_t WS_QB = WS_QKV + (size_t)MTOT * NQKV * 4;
constexpr size_t WS_KB = WS_QB + (size_t)MLAT * DM * 2;
constexpr size_t WS_VB = WS_KB + (size_t)NBATCH * TKV * KVD * 2;
constexpr size_t WS_OB = WS_VB + (size_t)NBATCH * TKV * KVD * 2;
constexpr size_t WS_END = WS_OB + (size_t)MLAT * DM * 2;

struct Params {
    const float* in[29];
    float* out;
    unsigned char* ws;
    int ph_lo, ph_hi;
};

__device__ __forceinline__ unsigned cvt_pk_bf16(float lo, float hi) { unsigned r; asm volatile("v_cvt_pk_bf16_f32 %0, %1, %2" : "=v"(r) : "v"(lo), "v"(hi)); return r; }
__device__ __forceinline__ float fast_rcp(float x) { return __builtin_amdgcn_rcpf(x); }
__device__ __forceinline__ float sigmoidf_(float x) { return fast_rcp(1.f + __expf(-x)); }
__device__ __forceinline__ float siluf_(float x) { return x * sigmoidf_(x); }
__device__ __forceinline__ float gelu_tanh(float x) { const float y = 0.7978845608028654f * (x + 0.044715f * x * x * x); return x * sigmoidf_(2.f * y); }
__device__ __forceinline__ float wave_sum(float v) {
#pragma unroll
    for (int o = 32; o > 0; o >>= 1) v += __shfl_xor(v, o, 64);
    return v;
}
__device__ __forceinline__ int otid() { int t = threadIdx.x; asm volatile("" : "+v"(t)); return t; }
__device__ __forceinline__ int obid() { int b = blockIdx.x; asm volatile("" : "+s"(b)); return b; }
#define WAVE_LDS_SYNC() asm volatile("s_waitcnt lgkmcnt(0)" ::: "memory")

namespace pg8 {
constexpr int BM = 256, BK = 64, HALF = 128, HTB = HALF * BK * 2, STAGE_BYTES = 8 * HTB, NXCD = 8, WGM = 8;
__host__ __device__ __forceinline__ int lds_byte(int r, int c) { const int st = (r >> 4) * 2 + (c >> 5), rr = r & 15, cc = c & 31, ob = rr * 64 + cc * 2; return st * 1024 + (ob ^ (((ob >> 9) & 1) << 5)); }
__host__ __device__ __forceinline__ void stage_rc(int b, int& R, int& C) { const int st = b / 1024, sb = b % 1024, swz = sb ^ (((sb >> 9) & 1) << 5); R = (st >> 1) * 16 + swz / 64; C = (st & 1) * 32 + (swz % 64) / 2; }
__host__ __device__ __forceinline__ int perm32(int rho) { const int n = rho >> 4, i = rho & 15; return 8 * (i >> 2) + 4 * n + (i & 3); }
struct Unit { int pm, pn; };
struct Gemm { const bf16_t* A; const bf16_t* Bt; int M, N, K; };
struct StaticOrder {
    int nM, nN, nwg, G, c;
    __device__ void init(int M, int N, int G_, int c_) { nM = M / BM; nN = N / BM; nwg = nM * nN; G = G_; c = c_; }
    __device__ bool next(int i, Unit& u) const {
        const long L = (long)i * G + c; if (L >= nwg) return false;
        int wgid = (int)L; { const int q = nwg / NXCD, r = nwg % NXCD, xcd = wgid % NXCD, off = wgid / NXCD; wgid = (xcd < r ? xcd * (q + 1) : r * (q + 1) + (xcd - r) * q) + off; }
        const int nig = WGM * nN, gid = wgid / nig, fm = gid * WGM, gsz = (nM - fm) < WGM ? (nM - fm) : WGM;
        u.pm = fm + ((wgid % nig) % gsz); u.pn = (wgid % nig) / gsz; return true;
    }
};

struct EpiAny;
__device__ __forceinline__ void epi_any(const EpiAny& E, const f32x4 (&acc)[2][2][4][2], const Unit& u, int wr, int wc, int fr, int fq);
__device__ __forceinline__ void gemm_phase(LAS unsigned char* lds, const Gemm g, const StaticOrder& S, const EpiAny& E, const bool PERMB) {
    const int tid = otid(), wid = __builtin_amdgcn_readfirstlane(tid >> 6), lane = tid & 63, wr = wid >> 2, wc = wid & 3, fr = lane & 15, fq = lane >> 4;
    const int K = g.K, nt = K / BK;
    unsigned voffA[2], voffB[2];
#pragma unroll
    for (int i = 0; i < 2; ++i) { int R, C; stage_rc(tid * 16 + i * 8192, R, C); const int Rb = PERMB ? ((R & ~31) + perm32(R & 31)) : R;
        voffA[i] = (unsigned)(R * K + C) * 2u; voffB[i] = (unsigned)(Rb * K + C) * 2u; }
    const size_t kstep = (size_t)(BK * 2);
    const size_t hstep = (size_t)HALF * K * 2;
    const size_t tstep = 2 * hstep;
    const unsigned ldsw = (unsigned)wid * 1024u;
    const int aoff = lds_byte(wr * 64 + fr, fq * 8), boff = lds_byte(wc * 32 + fr, fq * 8);
#define PG8_SA(b, h) (((b) * 2 + (h)) * HTB)
#define PG8_SB(b, h) ((4 + (b) * 2 + (h)) * HTB)
#define PG8_STAGE(bufoff, gbase, voff) do { _Pragma("unroll") for (int _i = 0; _i < 2; ++_i) \
        __builtin_amdgcn_global_load_lds((const unsigned*)((const char*)(gbase) + (voff)[_i]), (LAS unsigned*)(lds + (bufoff) + ldsw + _i * 8192), 16, 0, 0); } while (0)
#define PG8_LDA(dst, b, h) do { _Pragma("unroll") for (int m = 0; m < 4; ++m) _Pragma("unroll") for (int k = 0; k < 2; ++k) dst[m][k] = *(const LAS bf16x8*)(lds + PG8_SA(b, h) + aoff + m * 2048 + k * 1024); } while (0)
#define PG8_LDB(dst, b, h) do { _Pragma("unroll") for (int n = 0; n < 2; ++n) _Pragma("unroll") for (int k = 0; k < 2; ++k) dst[n][k] = *(const LAS bf16x8*)(lds + PG8_SB(b, h) + boff + n * 2048 + k * 1024); } while (0)
#define PG8_MMA(ai, bj, At, Bt) do { __builtin_amdgcn_s_setprio(1); _Pragma("unroll") for (int m = 0; m < 4; ++m) _Pragma("unroll") for (int n = 0; n < 2; ++n) _Pragma("unroll") for (int k = 0; k < 2; ++k) \
        acc[ai][bj][m][n] = __builtin_amdgcn_mfma_f32_16x16x32_bf16(Bt[n][k], At[m][k], acc[ai][bj][m][n], 0, 0, 0); __builtin_amdgcn_s_setprio(0); } while (0)
#define PG8_WAIT_V(n) asm volatile("s_waitcnt vmcnt(" #n ")" ::: "memory")
#define PG8_WAIT_L(n) asm volatile("s_waitcnt lgkmcnt(" #n ")" ::: "memory")
#define PG8_BAR __builtin_amdgcn_s_barrier()
#define PG8_SCHED __builtin_amdgcn_sched_barrier(0)
    Unit cur, nxt; int ui = 0;
    if (!S.next(0, cur)) return;
    f32x4 acc[2][2][4][2];
#pragma unroll
    for (int a = 0; a < 2; ++a)
#pragma unroll
        for (int b = 0; b < 2; ++b)
#pragma unroll
            for (int m = 0; m < 4; ++m)
#pragma unroll
                for (int n = 0; n < 2; ++n) acc[a][b][m][n] = (f32x4){0.f, 0.f, 0.f, 0.f};
    bf16x8 At[4][2], B0[2][2], B1[2][2];
    const char* cA = (const char*)g.A + (size_t)cur.pm * tstep; const char* cB = (const char*)g.Bt + (size_t)cur.pn * tstep;
    PG8_STAGE(PG8_SB(0, 0), cB, voffB); PG8_STAGE(PG8_SA(0, 0), cA, voffA); PG8_STAGE(PG8_SB(0, 1), cB + hstep, voffB); PG8_STAGE(PG8_SA(0, 1), cA + hstep, voffA);
    if (wr == 1) PG8_BAR;
    PG8_WAIT_V(4); PG8_BAR;
    PG8_STAGE(PG8_SB(1, 0), cB + kstep, voffB); PG8_STAGE(PG8_SA(1, 0), cA + kstep, voffA); PG8_STAGE(PG8_SB(1, 1), cB + hstep + kstep, voffB);
    PG8_WAIT_V(6); PG8_BAR;
    for (;;) {
        const bool has_next = S.next(ui + 1, nxt);
        const char* nA = has_next ? (const char*)g.A + (size_t)nxt.pm * tstep : cA; const char* nB = has_next ? (const char*)g.Bt + (size_t)nxt.pn * tstep : cB;
        for (int t = 0; t < nt; t += 2) {
            const bool last = (t == nt - 2);
            const char* a1 = cA + (size_t)(t + 1) * kstep;
            const char* a2 = last ? nA : cA + (size_t)(t + 2) * kstep; const char* b2 = last ? nB : cB + (size_t)(t + 2) * kstep;
            const char* a3 = a2 + kstep; const char* b3 = b2 + kstep;
            PG8_LDB(B0, 0, 0); PG8_SCHED; PG8_LDA(At, 0, 0); PG8_STAGE(PG8_SA(1, 1), a1 + hstep, voffA);
            PG8_WAIT_L(8); PG8_BAR; PG8_WAIT_L(0); PG8_MMA(0, 0, At, B0); PG8_BAR; PG8_SCHED;
            PG8_LDB(B1, 0, 1); PG8_STAGE(PG8_SB(0, 0), b2, voffB);
            PG8_BAR; PG8_WAIT_L(0); PG8_MMA(0, 1, At, B1); PG8_BAR;
            PG8_LDA(At, 0, 1); PG8_STAGE(PG8_SA(0, 0), a2, voffA);
            PG8_BAR; PG8_WAIT_L(0); PG8_MMA(1, 0, At, B0); PG8_BAR; PG8_SCHED;
            PG8_STAGE(PG8_SB(0, 1), b2 + hstep, voffB);
            PG8_WAIT_V(6); PG8_BAR; PG8_MMA(1, 1, At, B1); PG8_BAR;
            PG8_LDB(B0, 1, 0); PG8_SCHED; PG8_LDA(At, 1, 0); PG8_STAGE(PG8_SA(0, 1), a2 + hstep, voffA);
            PG8_WAIT_L(8); PG8_BAR; PG8_WAIT_L(0); PG8_MMA(0, 0, At, B0); PG8_BAR; PG8_SCHED;
            PG8_LDB(B1, 1, 1); PG8_STAGE(PG8_SB(1, 0), b3, voffB);
            PG8_BAR; PG8_WAIT_L(0); PG8_MMA(0, 1, At, B1); PG8_BAR;
            PG8_LDA(At, 1, 1); PG8_STAGE(PG8_SA(1, 0), a3, voffA);
            PG8_BAR; PG8_WAIT_L(0); PG8_MMA(1, 0, At, B0); PG8_BAR; PG8_SCHED;
            PG8_STAGE(PG8_SB(1, 1), b3 + hstep, voffB);
            PG8_WAIT_V(6); PG8_BAR; PG8_MMA(1, 1, At, B1); PG8_BAR;
        }
        epi_any(E, acc, cur, wr, wc, fr, fq);
        if (!has_next) break;
#pragma unroll
        for (int a = 0; a < 2; ++a)
#pragma unroll
            for (int b = 0; b < 2; ++b)
#pragma unroll
                for (int m = 0; m < 4; ++m)
#pragma unroll
                    for (int n = 0; n < 2; ++n) acc[a][b][m][n] = (f32x4){0.f, 0.f, 0.f, 0.f};
        cur = nxt; cA = nA; cB = nB; ++ui;
    }
    PG8_WAIT_V(0);
    if (wr == 0) PG8_BAR;
    PG8_BAR;
#undef PG8_SA
#undef PG8_SB
#undef PG8_STAGE
#undef PG8_LDA
#undef PG8_LDB
#undef PG8_MMA
#undef PG8_WAIT_V
#undef PG8_WAIT_L
#undef PG8_BAR
#undef PG8_SCHED
}

struct EpiSwiglu {
    static constexpr bool PERM = true;
    bf16_t* O; int ldo;
    __device__ __forceinline__ void operator()(const f32x4 (&acc)[2][2][4][2], const Unit& u, int wr, int wc, int fr, int fq) const {
        const int row0 = u.pm * BM + wr * 64 + fr, col0 = u.pn * HALF + wc * 32 + 8 * fq;
#pragma unroll
        for (int ai = 0; ai < 2; ++ai)
#pragma unroll
            for (int m = 0; m < 4; ++m) {
                bf16_t* rowp = O + (size_t)(row0 + ai * HALF + m * 16) * ldo + col0;
                float v[8];
#pragma unroll
                for (int n = 0; n < 2; ++n)
#pragma unroll
                    for (int j = 0; j < 4; ++j) { const float gt = acc[ai][0][m][n][j], up = acc[ai][1][m][n][j]; v[n * 4 + j] = siluf_(gt) * up; }
                u32x4 w; w.x = cvt_pk_bf16(v[0], v[1]); w.y = cvt_pk_bf16(v[2], v[3]); w.z = cvt_pk_bf16(v[4], v[5]); w.w = cvt_pk_bf16(v[6], v[7]);
                *(u32x4*)rowp = w;
            }
    }
};
struct EpiResid {
    static constexpr bool PERM = false;
    const float* res_lat; const float* res_ctx; float* out_lat; float* out_ctx; const float* gate; float coef;
    __device__ __forceinline__ void operator()(const f32x4 (&acc)[2][2][4][2], const Unit& u, int wr, int wc, int fr, int fq) const {
        const int row0 = u.pm * BM + wr * 64 + fr, col0 = u.pn * BM + wc * 32 + 4 * fq;
        const bool isl = u.pm < MLAT / BM; const int mrow = isl ? (u.pm >> 3) : 4;
        const float* rb = isl ? res_lat : res_ctx - (size_t)MLAT * DM; float* ob = isl ? out_lat : out_ctx - (size_t)MLAT * DM;
        const float* gp = gate + (size_t)mrow * NMODC;
        f32x4 gv[2][2];
#pragma unroll
        for (int bj = 0; bj < 2; ++bj)
#pragma unroll
            for (int n = 0; n < 2; ++n) gv[bj][n] = *(const f32x4*)(gp + col0 + bj * HALF + n * 16) * coef;
#pragma unroll
        for (int ai = 0; ai < 2; ++ai)
#pragma unroll
            for (int m = 0; m < 4; ++m) {
                const size_t ro = (size_t)(row0 + ai * HALF + m * 16) * DM + col0;
#pragma unroll
                for (int bj = 0; bj < 2; ++bj)
#pragma unroll
                    for (int n = 0; n < 2; ++n) { const f32x4 r = *(const f32x4*)(rb + ro + bj * HALF + n * 16); *(f32x4*)(ob + ro + bj * HALF + n * 16) = r + gv[bj][n] * acc[ai][bj][m][n]; }
            }
    }
};
struct EpiGlu {
    static constexpr bool PERM = false;
    float* h; const float* gate;
    __device__ __forceinline__ void operator()(const f32x4 (&acc)[2][2][4][2], const Unit& u, int wr, int wc, int fr, int fq) const {
        const int row0 = u.pm * BM + wr * 64 + fr, col0 = u.pn * HALF + wc * 32 + 4 * fq;
        const int mrow = u.pm < MLAT / BM ? (u.pm >> 3) : 4;
        const float* gp = gate + (size_t)mrow * NMODC;
        f32x4 gv[2];
#pragma unroll
        for (int n = 0; n < 2; ++n) gv[n] = *(const f32x4*)(gp + col0 + n * 16);
#pragma unroll
        for (int ai = 0; ai < 2; ++ai)
#pragma unroll
            for (int m = 0; m < 4; ++m) {
                float* rowp = h + (size_t)(row0 + ai * HALF + m * 16) * DM + col0;
#pragma unroll
                for (int n = 0; n < 2; ++n) { f32x4 r = *(const f32x4*)(rowp + n * 16); const f32x4 a1 = acc[ai][0][m][n], a2 = acc[ai][1][m][n];
#pragma unroll
                    for (int j = 0; j < 4; ++j) r[j] += gv[n][j] * a1[j] * sigmoidf_(a2[j]);
                    *(f32x4*)(rowp + n * 16) = r; }
            }
    }
};
struct EpiF32 {
    static constexpr bool PERM = false;
    float* C; int ldc;
    __device__ __forceinline__ void operator()(const f32x4 (&acc)[2][2][4][2], const Unit& u, int wr, int wc, int fr, int fq) const {
        const int row0 = u.pm * BM + wr * 64 + fr, col0 = u.pn * BM + wc * 32 + 4 * fq;
#pragma unroll
        for (int ai = 0; ai < 2; ++ai)
#pragma unroll
            for (int m = 0; m < 4; ++m) { float* rowp = C + (size_t)(row0 + ai * HALF + m * 16) * ldc + col0;
#pragma unroll
                for (int bj = 0; bj < 2; ++bj)
#pragma unroll
                    for (int n = 0; n < 2; ++n) *(f32x4*)(rowp + bj * HALF + n * 16) = acc[ai][bj][m][n]; }
    }
};
struct EpiAny { int mode; EpiSwiglu sw; EpiResid rs; EpiGlu gl; EpiF32 f3; };
__device__ __forceinline__ void epi_any(const EpiAny& E, const f32x4 (&acc)[2][2][4][2], const Unit& u, int wr, int wc, int fr, int fq) {
    if (E.mode == 0) E.sw(acc, u, wr, wc, fr, fq);
    else if (E.mode == 1) E.rs(acc, u, wr, wc, fr, fq);
    else if (E.mode == 2) E.gl(acc, u, wr, wc, fr, fq);
    else E.f3(acc, u, wr, wc, fr, fq);
}
}

__device__ __forceinline__ void p0_phase(const Params& P, unsigned char* lds_raw) {
    const int tid = otid(), lane = tid & 63, w = tid >> 6;
    float* s_lds = (float*)lds_raw;
    float* red = s_lds + 5 * DM;
    const float* c = P.in[1]; const float* cc = P.in[3];
    for (int i = tid; i < 5 * DM; i += 512) { const int r = i >> 11, k = i & (DM - 1); const float v = r < 4 ? c[r * DM + k] : cc[k]; s_lds[i] = siluf_(v); }
    __syncthreads();
    const float* ada_w = P.in[4]; const float* ada_b = P.in[5];
    float* mod = (float*)(P.ws + WS_MOD);
    const int G = gridDim.x, bx = obid();
    for (int item = bx; item < 576; item += G) {
        const int l = item / 288, n0 = (item % 288) * 64;
        const float* wp = ada_w + ((size_t)l * DM + w * 256) * NMODC + n0 + lane;
        float a0 = 0.f, a1 = 0.f, a2 = 0.f, a3 = 0.f, a4 = 0.f;
        const float* sp = s_lds + w * 256;
#pragma unroll 1
        for (int k0 = 0; k0 < 256; k0 += 16) {
            float wv[16];
#pragma unroll
            for (int j = 0; j < 16; ++j) wv[j] = __builtin_nontemporal_load(wp + (size_t)(k0 + j) * NMODC);
#pragma unroll
            for (int j = 0; j < 16; ++j) { const int k = k0 + j; a0 += sp[k] * wv[j]; a1 += sp[DM + k] * wv[j]; a2 += sp[2 * DM + k] * wv[j]; a3 += sp[3 * DM + k] * wv[j]; a4 += sp[4 * DM + k] * wv[j]; }
        }
        red[(w * 5 + 0) * 64 + lane] = a0; red[(w * 5 + 1) * 64 + lane] = a1; red[(w * 5 + 2) * 64 + lane] = a2; red[(w * 5 + 3) * 64 + lane] = a3; red[(w * 5 + 4) * 64 + lane] = a4;
        __syncthreads();
        if (tid < 320) { const int r = tid >> 6; float s = ada_b[(size_t)l * NMODC + n0 + lane];
#pragma unroll
            for (int ww = 0; ww < 8; ++ww) s += red[(ww * 5 + r) * 64 + lane];
            mod[((size_t)l * 5 + r) * NMODC + n0 + lane] = s; }
        __syncthreads();
    }
    int t_lo, t_hi;
    if (G == 256) { if (bx < 64) { t_lo = 31 * bx; t_hi = t_lo + 31; } else { t_lo = 1984 + (int)(((long)(bx - 64) * 7616) / 192); t_hi = 1984 + (int)(((long)(bx - 63) * 7616) / 192); } }
    else { t_lo = (int)(((long)bx * 9600) / G); t_hi = (int)(((long)(bx + 1) * 9600) / G); }
    for (int t = t_lo; t < t_hi; ++t) {
        const float* src; bf16_t* dst; int K, N, nb, kb, pair;
        if (t < 8448) {
            const int q = t / 704, r = t % 704, lf = q / 3, kind = q % 3, l = lf >> 1, f = lf & 1;
            if (kind < 2) { K = DM; N = DFF; nb = r >> 3; kb = r & 7; src = P.in[9 + f * 3 + kind] + (size_t)l * DM * DFF; dst = (bf16_t*)(P.ws + WS_WGU + (size_t)lf * SZ_WGU); pair = 1 + kind; }
            else { K = DFF; N = DM; nb = r / 22; kb = r % 22; src = P.in[11 + f * 3] + (size_t)l * DM * DFF; dst = (bf16_t*)(P.ws + WS_WD + (size_t)lf * SZ_WD); pair = 0; }
        } else {
            const int r = t - 8448;
            if (r < 512) { K = DM; N = DM; nb = (r & 255) >> 3; kb = r & 7; src = P.in[r < 256 ? 23 : 24]; dst = (bf16_t*)(P.ws + WS_W12); pair = r < 256 ? 1 : 2; }
            else if (r < 896) { const int r2 = r - 512; K = DM; N = NQKV; nb = r2 >> 3; kb = r2 & 7; src = P.in[25]; dst = (bf16_t*)(P.ws + WS_WQKV); pair = 0; }
            else { const int r2 = r - 896; K = DM; N = DM; nb = r2 >> 3; kb = r2 & 7; src = P.in[26]; dst = (bf16_t*)(P.ws + WS_WO); pair = 0; }
        }
        const int n = nb * 64 + lane, k0 = kb * 256 + w * 32;
        const int nr = pair == 0 ? n : ((n >> 7) * 256 + (pair - 1) * 128 + (n & 127));
        const float* sp = src + (size_t)k0 * N + n;
        float v[32];
#pragma unroll
        for (int j = 0; j < 32; ++j) v[j] = __builtin_nontemporal_load(sp + (size_t)j * N);
        bf16_t* dp = dst + (size_t)nr * K + k0;
#pragma unroll
        for (int cblk = 0; cblk < 4; ++cblk) { u32x4 o; o.x = cvt_pk_bf16(v[cblk * 8 + 0], v[cblk * 8 + 1]); o.y = cvt_pk_bf16(v[cblk * 8 + 2], v[cblk * 8 + 3]); o.z = cvt_pk_bf16(v[cblk * 8 + 4], v[cblk * 8 + 5]); o.w = cvt_pk_bf16(v[cblk * 8 + 6], v[cblk * 8 + 7]);
            *(u32x4*)(dp + cblk * 8) = o; }
    }
}

__device__ __forceinline__ void normmod_phase(const float* src_lat, const float* src_ctx, int nrows, const float* gnorm, const float* modl, int ch_shift, int ch_scale, bf16_t* dst) {
    const int lane = otid() & 63, gw = obid() * 8 + (otid() >> 6), nw = gridDim.x * 8;
    for (int row = gw; row < nrows; row += nw) {
        const float* sp = row < MLAT ? src_lat + (size_t)row * DM : src_ctx + (size_t)(row - MLAT) * DM;
        const int mrow = row < MLAT ? (row >> 11) : 4;
        const float* shp = modl + (size_t)mrow * NMODC + ch_shift * DM; const float* scp = modl + (size_t)mrow * NMODC + ch_scale * DM;
        f32x4 v[8]; float ss = 0.f;
#pragma unroll
        for (int i = 0; i < 8; ++i) { v[i] = *(const f32x4*)(sp + (i * 64 + lane) * 4); ss += v[i][0] * v[i][0] + v[i][1] * v[i][1] + v[i][2] * v[i][2] + v[i][3] * v[i][3]; }
        ss = wave_sum(ss);
        const float r = rsqrtf(ss * (1.f / DM) + 1e-6f);
        bf16_t* dp = dst + (size_t)row * DM;
#pragma unroll
        for (int i = 0; i < 8; ++i) { const int d = (i * 64 + lane) * 4; const f32x4 g4 = *(const f32x4*)(gnorm + d), sc = *(const f32x4*)(scp + d), sh = *(const f32x4*)(shp + d);
            f32x4 o;
#pragma unroll
            for (int j = 0; j < 4; ++j) o[j] = v[i][j] * r * g4[j] * (1.f + sc[j]) + sh[j];
            u32x2 pk; pk.x = cvt_pk_bf16(o[0], o[1]); pk.y = cvt_pk_bf16(o[2], o[3]); *(u32x2*)(dp + d) = pk; }
    }
}

__device__ __forceinline__ int crow(int r, int hi) { return (r & 3) + 8 * (r >> 2) + 4 * hi; }
constexpr int S5_BU_BYTES = 32 * 128 * 4, S5_HS_STRIDE = 272, S5_HS_BYTES = 32 * S5_HS_STRIDE, S5_WAVE_BYTES = S5_BU_BYTES + S5_HS_BYTES;
__device__ __forceinline__ void s5_phase(const Params& P, unsigned char* lds_raw) {
    const int tid = otid(), lane = tid & 63, w = tid >> 6;
    if (w >= 4) return;
    float* bu = (float*)(lds_raw + w * S5_WAVE_BYTES);
    unsigned char* hs = lds_raw + w * S5_WAVE_BYTES + S5_BU_BYTES;
    const bf16_t* U = (const bf16_t*)(P.ws + WS_A);
    const float* a_re = P.in[15]; const float* a_im = P.in[16]; const float* log_dt = P.in[17];
    const float* b_re = P.in[18]; const float* b_im = P.in[19]; const float* c_re = P.in[20]; const float* c_im = P.in[21];
    const int l31 = lane & 31, hi = lane >> 5, l15 = lane & 15, q4 = lane >> 4;
    for (int item = obid() * 4 + w; item < 1024; item += gridDim.x * 4) {
        const int dir = item & 1, g = (item >> 1) & 127, b = item >> 8;
        const int base = dir * 128 + g;
        const float dt = expf(log_dt[base]);
        float lre, lim;
        { const float are = a_re[base * 64 + lane], aim = a_im[base * 64 + lane]; const float mag = expf(are * dt); float s, c; sincosf(aim * dt, &s, &c); lre = mag * c; lim = mag * s; }
        bf16x8 Bf[4];
#pragma unroll
        for (int nb = 0; nb < 4; ++nb) {
            const int q = (nb & 1) * 32 + l31, comp = nb >> 1;
            const float are = a_re[base * 64 + q], aim = a_im[base * 64 + q]; const float mag = expf(are * dt); float s, c; sincosf(aim * dt, &s, &c);
            const float nre = mag * c - 1.f, nim = mag * s, den = fast_rcp(are * are + aim * aim);
            const float cre = (nre * are + nim * aim) * den, cim = (nim * are - nre * aim) * den;
            const float* br = b_re + ((size_t)base * 64 + q) * 16 + 8 * hi; const float* bi = b_im + ((size_t)base * 64 + q) * 16 + 8 * hi;
            float o[8];
#pragma unroll
            for (int j = 0; j < 8; ++j) { const float xr = br[j], xi = bi[j]; o[j] = comp == 0 ? (cre * xr - cim * xi) : (cre * xi + cim * xr); }
            u32x4 pk; pk.x = cvt_pk_bf16(o[0], o[1]); pk.y = cvt_pk_bf16(o[2], o[3]); pk.z = cvt_pk_bf16(o[4], o[5]); pk.w = cvt_pk_bf16(o[6], o[7]);
            Bf[nb] = *(bf16x8*)&pk;
        }
        bf16x8 Cf[4];
#pragma unroll
        for (int kb = 0; kb < 4; ++kb) {
            float o[8];
#pragma unroll
            for (int j = 0; j < 8; ++j) { const int k = kb * 32 + 8 * q4 + j, p = k >> 1; const size_t ci = ((size_t)base * 16 + l15) * 64 + p; o[j] = (k & 1) ? -c_im[ci] : c_re[ci]; }
            u32x4 pk; pk.x = cvt_pk_bf16(o[0], o[1]); pk.y = cvt_pk_bf16(o[2], o[3]); pk.z = cvt_pk_bf16(o[4], o[5]); pk.w = cvt_pk_bf16(o[6], o[7]);
            Cf[kb] = *(bf16x8*)&pk;
        }
        float* Y = (float*)(P.ws + (dir ? WS_YB : WS_YF));
        float hre = 0.f, him = 0.f;
        auto rowof = [&](int blk, int t) -> int {
            const int tau = blk * 32 + t;
            if (tau < CTXL) return MLAT + b * CTXL + (dir ? (CTXL - 1 - tau) : tau);
            const int s = tau - CTXL; return b * SEQ + (dir ? (SEQ - 1 - s) : s);
        };
        bf16x8 afr = *(const bf16x8*)(U + (size_t)rowof(0, l31) * DM + g * 16 + 8 * hi);
#pragma unroll 1
        for (int blk = 0; blk < 72; ++blk) {
            const bf16x8 acur = afr;
            if (blk + 1 < 72) afr = *(const bf16x8*)(U + (size_t)rowof(blk + 1, l31) * DM + g * 16 + 8 * hi);
#pragma unroll
            for (int nb = 0; nb < 4; ++nb) {
                f32x16 acc = {};
                acc = __builtin_amdgcn_mfma_f32_32x32x16_bf16(acur, Bf[nb], acc, 0, 0, 0);
#pragma unroll
                for (int r = 0; r < 16; ++r) bu[crow(r, hi) * 128 + nb * 32 + l31] = acc[r];
            }
            WAVE_LDS_SYNC();
#pragma unroll 8
            for (int t = 0; t < 32; ++t) {
                const float bre = bu[t * 128 + lane], bim = bu[t * 128 + 64 + lane];
                const float nre = fmaf(lre, hre, fmaf(-lim, him, bre)), nim = fmaf(lre, him, fmaf(lim, hre, bim));
                hre = nre; him = nim;
                *(unsigned*)(hs + t * S5_HS_STRIDE + lane * 4) = cvt_pk_bf16(hre, him);
            }
            WAVE_LDS_SYNC();
#pragma unroll
            for (int tb = 0; tb < 2; ++tb) {
                f32x4 acc = {0.f, 0.f, 0.f, 0.f};
#pragma unroll
                for (int kb = 0; kb < 4; ++kb) { const bf16x8 a = *(const bf16x8*)(hs + (tb * 16 + l15) * S5_HS_STRIDE + kb * 64 + q4 * 16); acc = __builtin_amdgcn_mfma_f32_16x16x32_bf16(a, Cf[kb], acc, 0, 0, 0); }
#pragma unroll
                for (int j = 0; j < 4; ++j) Y[(size_t)rowof(blk, tb * 16 + q4 * 4 + j) * DM + g * 16 + l15] = acc[j];
            }
            WAVE_LDS_SYNC();
        }
    }
}

__device__ __forceinline__ void s5_merge_phase(const Params& P) {
    const float* yf = (const float*)(P.ws + WS_YF); const float* yb = (const float*)(P.ws + WS_YB); const bf16_t* U = (const bf16_t*)(P.ws + WS_A); bf16_t* Z = (bf16_t*)(P.ws + WS_Z);
    const float* dsk = P.in[22];
    const size_t n4 = (size_t)MTOT * DM / 4, stride = (size_t)gridDim.x * 512;
    for (size_t i = (size_t)obid() * 512 + otid(); i < n4; i += stride) {
        const f32x4 a = *(const f32x4*)(yf + i * 4), bq = *(const f32x4*)(yb + i * 4); const u32x2 uu = *(const u32x2*)(U + i * 4); const f32x4 d4 = *(const f32x4*)(dsk + ((i * 4) & (DM - 1)));
        const float u0 = __uint_as_float(uu.x << 16), u1 = __uint_as_float(uu.x & 0xffff0000u), u2 = __uint_as_float(uu.y << 16), u3 = __uint_as_float(uu.y & 0xffff0000u);
        const float z0 = gelu_tanh(a[0] + bq[0] + d4[0] * u0), z1 = gelu_tanh(a[1] + bq[1] + d4[1] * u1), z2 = gelu_tanh(a[2] + bq[2] + d4[2] * u2), z3 = gelu_tanh(a[3] + bq[3] + d4[3] * u3);
        u32x2 o; o.x = cvt_pk_bf16(z0, z1); o.y = cvt_pk_bf16(z2, z3); *(u32x2*)(Z + i * 4) = o;
    }
}

__device__ __forceinline__ void qknorm_phase(const Params& P) {
    const float* QKV = (const float*)(P.ws + WS_QKV); bf16_t* QB = (bf16_t*)(P.ws + WS_QB); bf16_t* KB = (bf16_t*)(P.ws + WS_KB); bf16_t* VB = (bf16_t*)(P.ws + WS_VB);
    const float* qg = P.in[27]; const float* kg = P.in[28];
    const int lane = otid() & 63, gw = obid() * 8 + (otid() >> 6), nw = gridDim.x * 8;
    const int i31 = lane & 31, e1 = lane < 32 ? lane : 32 + lane, e2 = e1 + 32;
    const float freq = exp2f(-(float)i31 * (13.287712379549449f / 32.f));
    const float qg1 = qg[e1], qg2 = qg[e2], kg1 = kg[e1], kg2 = kg[e2];
    for (int row = gw; row < MTOT; row += nw) {
        const bool isl = row < MLAT;
        float cs = 1.f, sn = 0.f; int kvrow;
        if (isl) { const int b = row >> 11, s = row & (SEQ - 1); const int pos = lane < 32 ? (s >> 6) : (s & 63); sincosf((float)pos * freq, &sn, &cs); kvrow = b * TKV + CTXL + s; }
        else { const int r = row - MLAT, b = r >> 8, lidx = r & (CTXL - 1); kvrow = b * TKV + lidx; }
        const float* rp = QKV + (size_t)row * NQKV;
        const int nh = isl ? 20 : 4, h0 = isl ? 0 : 16;
        for (int hh = 0; hh < nh; ++hh) {
            const int h = h0 + hh; const bool isq = h < 16;
            const float x1 = rp[h * 128 + e1], x2 = rp[h * 128 + e2];
            const float ss = wave_sum(x1 * x1 + x2 * x2);
            const float r = rsqrtf(ss * (1.f / 128.f) + 1e-6f);
            const float y1 = x1 * r * (isq ? qg1 : kg1), y2 = x2 * r * (isq ? qg2 : kg2);
            const float o1 = y1 * cs - y2 * sn, o2 = y2 * cs + y1 * sn;
            bf16_t* dp = isq ? QB + (size_t)row * DM + h * 128 : KB + (size_t)kvrow * KVD + (h - 16) * 128;
            const unsigned pk = cvt_pk_bf16(o1, o2);
            dp[e1] = (bf16_t)(pk & 0xffffu); dp[e2] = (bf16_t)(pk >> 16);
        }
        const f32x4 v0 = *(const f32x4*)(rp + 2560 + lane * 8), v1 = *(const f32x4*)(rp + 2560 + lane * 8 + 4);
        u32x4 o; o.x = cvt_pk_bf16(v0[0], v0[1]); o.y = cvt_pk_bf16(v0[2], v0[3]); o.z = cvt_pk_bf16(v1[0], v1[1]); o.w = cvt_pk_bf16(v1[2], v1[3]);
        *(u32x4*)(VB + (size_t)kvrow * KVD + lane * 8) = o;
    }
}

namespace att {
constexpr int D = 128, NW = 8, QBLK = 32, KVBLK = 64;
constexpr float SCALE = 0.088388347648318440f;
constexpr float THR = 8.f;
constexpr int LDQ = DM, LDK = KVD, LDO = DM;
constexpr size_t SHM_V = KVBLK * D * 2, SHM_K = KVBLK * D * 2;
#define KSWZ(row, colB) ((row) * 256 + ((colB) ^ (((row) & 7) << 4)))
#define SBAR() __builtin_amdgcn_sched_barrier(0)
__device__ __forceinline__ void partialSM(f32x16& p0, f32x16& p1, float& m_reg, float& mn, float& alpha) {
  constexpr float C = SCALE * 1.4426950408889634f;
  float pmax = p0[0];
#pragma unroll
  for (int r = 1; r < 16; ++r) pmax = fmaxf(pmax, p0[r]);
#pragma unroll
  for (int r = 0; r < 16; ++r) pmax = fmaxf(pmax, p1[r]);
  { auto rr = __builtin_amdgcn_permlane32_swap(__float_as_uint(pmax), __float_as_uint(pmax), false, false);
    pmax = fmaxf(__uint_as_float(rr[0]), __uint_as_float(rr[1])); }
  if (__builtin_expect(__all(pmax - m_reg <= THR / SCALE), 1)) { mn = m_reg; alpha = 1.f; }
  else { mn = fmaxf(m_reg, pmax); alpha = __builtin_amdgcn_exp2f((m_reg - mn) * C); m_reg = mn; }
  float mnC = -mn * C;
#pragma unroll
  for (int r = 0; r < 16; ++r) p0[r] = fmaf(p0[r], C, mnC);
#pragma unroll
  for (int r = 0; r < 16; ++r) p1[r] = fmaf(p1[r], C, mnC);
#pragma unroll
  for (int r = 0; r < 16; ++r) p0[r] = __builtin_amdgcn_exp2f(p0[r]);
}
__device__ __forceinline__ void finishSM(f32x16& p0, f32x16& p1, float alpha, float& l_reg, bf16x8& pa0, bf16x8& pa1, bf16x8& pa2, bf16x8& pa3) {
#pragma unroll
  for (int r = 0; r < 16; ++r) p1[r] = __builtin_amdgcn_exp2f(p1[r]);
  float ps = 0;
#pragma unroll
  for (int r = 0; r < 16; ++r) ps += p0[r];
#pragma unroll
  for (int r = 0; r < 16; ++r) ps += p1[r];
  { auto rr = __builtin_amdgcn_permlane32_swap(__float_as_uint(ps), __float_as_uint(ps), false, false);
    ps = __uint_as_float(rr[0]) + __uint_as_float(rr[1]); }
  l_reg = l_reg * alpha + ps;
#define PK4(P, BASE, OUT) do { unsigned a0 = cvt_pk_bf16(P[BASE + 0], P[BASE + 1]), a1 = cvt_pk_bf16(P[BASE + 2], P[BASE + 3]);   \
    unsigned b0 = cvt_pk_bf16(P[BASE + 4], P[BASE + 5]), b1 = cvt_pk_bf16(P[BASE + 6], P[BASE + 7]);                              \
    auto r0 = __builtin_amdgcn_permlane32_swap(a0, b0, false, false); auto r1 = __builtin_amdgcn_permlane32_swap(a1, b1, false, false); \
    u32x4 w = {r0[0], r1[0], r0[1], r1[1]}; OUT = *reinterpret_cast<bf16x8*>(&w); } while (0)
  PK4(p0, 0, pa0); PK4(p0, 8, pa1); PK4(p1, 0, pa2); PK4(p1, 8, pa3);
#undef PK4
}
__device__ __forceinline__ void qkt(f32x16& p0, f32x16& p1, const bf16_t* Ks, const bf16x8* qr, int r32, int hi) {
  p0 = f32x16{}; p1 = f32x16{};
#pragma unroll
  for (int d0 = 0; d0 < 8; ++d0) { int cb = (d0 * 16 + hi * 8) * 2;
    bf16x8 b0 = *reinterpret_cast<const bf16x8*>((const char*)Ks + KSWZ(r32, cb));
    bf16x8 b1 = *reinterpret_cast<const bf16x8*>((const char*)Ks + KSWZ(32 + r32, cb));
    p0 = __builtin_amdgcn_mfma_f32_32x32x16_bf16(b0, qr[d0], p0, 0, 0, 0);
    p1 = __builtin_amdgcn_mfma_f32_32x32x16_bf16(b1, qr[d0], p1, 0, 0, 0); }
}
__device__ __forceinline__ int v_st(int k, int c) { const int kk = (k & ~0xC) | ((k & 4) << 1) | ((k & 8) >> 1); return ((kk >> 3) * 4 + (c >> 5)) * 512 + ((kk & 7) * 32 + (c & 31)) * 2; }
__device__ __forceinline__ int v_rd_base(int lane) { return ((lane & 3) << 3) | (((lane >> 2) & 3) << 6) | (((lane >> 4) & 1) << 5) | (((lane >> 5) & 1) << 8); }
constexpr int v_rd_off(int d0, int ks, int half) { return d0 * 512 + ks * 4096 + half * 2048; }
template <int OFF> __device__ __forceinline__ s16x4 tr_read(int vb) {
  s16x4 r; asm volatile("ds_read_b64_tr_b16 %0, %1 offset:%2" : "=&v"(r) : "v"(vb), "i"(OFF) : "memory"); return r;
}
template <int D0> __device__ __forceinline__ void pv_one(f32x16& od, int vb, bf16x8 pa0, bf16x8 pa1, bf16x8 pa2, bf16x8 pa3) {
  const s16x4 l0 = tr_read<v_rd_off(D0, 0, 0)>(vb), h0 = tr_read<v_rd_off(D0, 0, 1)>(vb), l1 = tr_read<v_rd_off(D0, 1, 0)>(vb), h1 = tr_read<v_rd_off(D0, 1, 1)>(vb);
  const s16x4 l2 = tr_read<v_rd_off(D0, 2, 0)>(vb), h2 = tr_read<v_rd_off(D0, 2, 1)>(vb), l3 = tr_read<v_rd_off(D0, 3, 0)>(vb), h3 = tr_read<v_rd_off(D0, 3, 1)>(vb);
  asm volatile("s_waitcnt lgkmcnt(0)" ::: "memory"); SBAR();
#define PK(L, H) (bf16x8){L[0], L[1], L[2], L[3], H[0], H[1], H[2], H[3]}
  od = __builtin_amdgcn_mfma_f32_32x32x16_bf16(pa0, PK(l0, h0), od, 0, 0, 0);
  od = __builtin_amdgcn_mfma_f32_32x32x16_bf16(pa1, PK(l1, h1), od, 0, 0, 0);
  od = __builtin_amdgcn_mfma_f32_32x32x16_bf16(pa2, PK(l2, h2), od, 0, 0, 0);
  od = __builtin_amdgcn_mfma_f32_32x32x16_bf16(pa3, PK(l3, h3), od, 0, 0, 0);
#undef PK
}
__device__ __forceinline__ void pv_d0(f32x16* o, int vb, bf16x8 pa0, bf16x8 pa1, bf16x8 pa2, bf16x8 pa3) {
  pv_one<0>(o[0], vb, pa0, pa1, pa2, pa3); pv_one<1>(o[1], vb, pa0, pa1, pa2, pa3); pv_one<2>(o[2], vb, pa0, pa1, pa2, pa3); pv_one<3>(o[3], vb, pa0, pa1, pa2, pa3);
}
__device__ __forceinline__ void attn_dense_body(const bf16_t* __restrict__ Qb, const bf16_t* __restrict__ Kh, const bf16_t* __restrict__ Vh, bf16_t* __restrict__ Ob, int seq, char* lds) {
  const int tid = otid(), wid = tid >> 6, lane = tid & 63, r32 = lane & 31, hi = lane >> 5;
  bf16_t* V_lds = (bf16_t*)lds; bf16_t* K_lds = (bf16_t*)(lds + 2 * SHM_V);
  float* ws = (float*)(lds + 2 * SHM_V + 2 * SHM_K) + wid * 64; float* li_l = ws; float* al_l = ws + 32;
  float m_reg = -1e30f, l_reg = 0; f32x16 o[4] = {}; bf16x8 qr[8];
  const bf16_t* Qw = Qb + (long)(wid * QBLK + r32) * LDQ + hi * 8;
#pragma unroll
  for (int d0 = 0; d0 < 8; ++d0) qr[d0] = *reinterpret_cast<const bf16x8*>(Qw + d0 * 16);
  const int sr = tid >> 4, sc = (tid & 15) * 8, vst0 = v_st(sr, sc), vst1 = v_st(32 + sr, sc);
  const int vb0 = (int)(uintptr_t)V_lds + v_rd_base(lane);
  struct { bf16x8 vs0, vs1, ks0, ks1; } sr_[2];
#define SLOAD(i, k0) do { sr_[i].vs0 = *reinterpret_cast<const bf16x8*>(&Vh[(long)((k0) + sr) * LDK + sc]); sr_[i].vs1 = *reinterpret_cast<const bf16x8*>(&Vh[(long)((k0) + 32 + sr) * LDK + sc]); \
    sr_[i].ks0 = *reinterpret_cast<const bf16x8*>(&Kh[(long)((k0) + sr) * LDK + sc]); sr_[i].ks1 = *reinterpret_cast<const bf16x8*>(&Kh[(long)((k0) + 32 + sr) * LDK + sc]); } while (0)
#define SWRITE(b, i) do { *(bf16x8*)((char*)V_lds + (b) * SHM_V + vst0) = sr_[i].vs0;          \
    *(bf16x8*)((char*)V_lds + (b) * SHM_V + vst1) = sr_[i].vs1; int kc = sc * 2;               \
    *(bf16x8*)((char*)K_lds + (b) * SHM_K + KSWZ(sr, kc)) = sr_[i].ks0;                       \
    *(bf16x8*)((char*)K_lds + (b) * SHM_K + KSWZ(32 + sr, kc)) = sr_[i].ks1; } while (0)
#define SWAIT() asm volatile("s_waitcnt vmcnt(4)" ::: "memory")
#define RESC(a) do { if (__any((a) < 1.f)) { if (hi == 0) al_l[r32] = (a); asm volatile("s_waitcnt lgkmcnt(0)" ::: "memory"); \
    _Pragma("unroll") for (int d = 0; d < 4; ++d) _Pragma("unroll") for (int r = 0; r < 16; ++r) o[d][r] *= al_l[crow(r, hi)]; } } while (0)
  f32x16 pA0, pA1, pB0, pB1; float mnA, mnB, alA, alB; bf16x8 pa0, pa1, pa2, pa3; const int NT = seq / KVBLK;
  constexpr int SE = 0, SO = 1;
  SLOAD(SE, 0); asm volatile("s_waitcnt vmcnt(0)" ::: "memory"); SWRITE(0, SE); __syncthreads();
  qkt(pA0, pA1, K_lds, qr, r32, hi); partialSM(pA0, pA1, m_reg, mnA, alA);
  SLOAD(SO, KVBLK); if (2 < NT) SLOAD(SE, 2 * KVBLK);
  SWAIT(); SWRITE(1, SO); __syncthreads();
  for (int j = 1; j + 1 < NT; j += 2) {
    SBAR(); qkt(pB0, pB1, (bf16_t*)((char*)K_lds + SHM_K), qr, r32, hi);
    finishSM(pA0, pA1, alA, l_reg, pa0, pa1, pa2, pa3); SBAR();
    SLOAD(SO, (j + 2) * KVBLK); SBAR();
    pv_d0(o, vb0, pa0, pa1, pa2, pa3); partialSM(pB0, pB1, m_reg, mnB, alB);
    __syncthreads(); SWAIT(); SWRITE(0, SE);
    RESC(alB); __syncthreads();
    SBAR(); qkt(pA0, pA1, K_lds, qr, r32, hi);
    finishSM(pB0, pB1, alB, l_reg, pa0, pa1, pa2, pa3); SBAR();
    if (j + 3 < NT) SLOAD(SE, (j + 3) * KVBLK); SBAR();
    pv_d0(o, vb0 + (int)SHM_V, pa0, pa1, pa2, pa3); partialSM(pA0, pA1, m_reg, mnA, alA);
    __syncthreads(); SWAIT(); SWRITE(1, SO);
    RESC(alA); __syncthreads();
  }
  SBAR(); qkt(pB0, pB1, (bf16_t*)((char*)K_lds + SHM_K), qr, r32, hi);
  finishSM(pA0, pA1, alA, l_reg, pa0, pa1, pa2, pa3); SBAR();
  pv_d0(o, vb0, pa0, pa1, pa2, pa3); partialSM(pB0, pB1, m_reg, mnB, alB);
  __syncthreads(); RESC(alB);
  finishSM(pB0, pB1, alB, l_reg, pa0, pa1, pa2, pa3); SBAR();
  pv_d0(o, vb0 + (int)SHM_V, pa0, pa1, pa2, pa3);
  if (hi == 0) li_l[r32] = l_reg; asm volatile("s_waitcnt lgkmcnt(0)" ::: "memory");
  float rli[16];
#pragma unroll
  for (int r = 0; r < 16; ++r) rli[r] = __builtin_amdgcn_rcpf(li_l[crow(r, hi)]);
  bf16_t* Ow = Ob + (long)(wid * QBLK) * LDO;
#pragma unroll
  for (int r = 0; r < 16; ++r) { int orow = crow(r, hi);
#pragma unroll
    for (int d0 = 0; d0 < 4; ++d0) { const unsigned pk = cvt_pk_bf16(o[d0][r] * rli[r], 0.f); Ow[(long)orow * LDO + d0 * 32 + r32] = (bf16_t)(pk & 0xffffu); } }
  __syncthreads();
#undef SLOAD
#undef SWRITE
#undef SWAIT
#undef RESC
}
}

__device__ __forceinline__ void attn_phase(const Params& P, unsigned char* lds_raw) {
    const bf16_t* QB = (const bf16_t*)(P.ws + WS_QB); const bf16_t* KB = (const bf16_t*)(P.ws + WS_KB); const bf16_t* VB = (const bf16_t*)(P.ws + WS_VB); bf16_t* OB = (bf16_t*)(P.ws + WS_OB);
    for (int u = obid(); u < 512; u += gridDim.x) {
        const int qblk = u & 7, hq = (u >> 3) & 15, b = u >> 7, kvh = hq >> 2;
        const size_t q0 = ((size_t)b * SEQ + qblk * 256) * DM + hq * 128, k0 = (size_t)b * TKV * KVD + kvh * 128;
        att::attn_dense_body(QB + q0, KB + k0, VB + k0, OB + q0, TKV, (char*)lds_raw);
    }
}

__global__ void __launch_bounds__(512, 2) fwd_kernel(Params P) {
    extern __shared__ __attribute__((aligned(16))) unsigned char lds[];
    cg::grid_group grid = cg::this_grid();
    unsigned char* ws = P.ws;
    float* H = (float*)(ws + WS_H); bf16_t* Abuf = (bf16_t*)(ws + WS_A); bf16_t* HID = (bf16_t*)(ws + WS_HID);
    const float* mod = (const float*)(ws + WS_MOD);
    const int G = gridDim.x;
#pragma unroll 1
    for (int ph = P.ph_lo; ph < P.ph_hi; ++ph) {
        if (ph > P.ph_lo) grid.sync();
        int kind = 0, l = ph >= 11 ? 1 : 0;
        switch (ph) {
            case 0: kind = 0; break;
            case 1: case 4: case 8: case 11: case 14: case 19: kind = 1; break;
            case 2: case 9: case 12: case 20: kind = 2; break;
            case 3: case 10: case 13: case 18: case 21: kind = 3; break;
            case 5: kind = 4; break;
            case 6: kind = 5; break;
            case 7: kind = 6; break;
            case 15: kind = 7; break;
            case 16: kind = 8; break;
            default: kind = 9; break;
        }
        const float* modl = mod + (size_t)l * 5 * NMODC;
        if (kind == 0) { p0_phase(P, lds); }
        else if (kind == 1) {
            const float* sl = H; const float* sx = H + (size_t)MLAT * DM; int nrows = MTOT; const float* gn; int chs, chc;
            if (ph == 1) { sl = P.in[0]; sx = P.in[2]; }
            if (ph == 19) nrows = MLAT;
            if (ph == 1 || ph == 11) { gn = P.in[6] + l * DM; chs = 0; chc = 1; }
            else if (ph == 4 || ph == 14) { gn = P.in[7] + l * DM; chs = 3; chc = 4; }
            else { gn = P.in[8] + l * DM; chs = 6; chc = 7; }
            normmod_phase(sl, sx, nrows, gn, modl, chs, chc, Abuf);
        }
        else if (kind == 2 || kind == 3 || kind == 6 || kind == 7) {
            pg8::Gemm g; pg8::EpiAny E;
            E.sw = pg8::EpiSwiglu{HID, DFF};
            E.rs.res_lat = H; E.rs.res_ctx = H + (size_t)MLAT * DM; E.rs.out_lat = H; E.rs.out_ctx = H + (size_t)MLAT * DM; E.rs.coef = 0.5f; E.rs.gate = modl;
            E.gl = pg8::EpiGlu{H, modl + (size_t)5 * DM};
            E.f3 = pg8::EpiF32{(float*)(ws + WS_QKV), NQKV};
            if (kind == 2) {
                const int wi = ph == 2 ? 0 : ph == 9 ? 1 : ph == 12 ? 2 : 3; const int M = ph == 20 ? MLAT : MTOT;
                g = pg8::Gemm{Abuf, (const bf16_t*)(ws + WS_WGU + (size_t)wi * SZ_WGU), M, 2 * DFF, DM}; E.mode = 0;
            } else if (kind == 3) {
                int ch = 2; E.mode = 1;
                if (ph == 18) { g = pg8::Gemm{(const bf16_t*)(ws + WS_OB), (const bf16_t*)(ws + WS_WO), MLAT, DM, DM}; ch = 5; E.rs.coef = 1.f; }
                else {
                    const int wi = ph == 3 ? 0 : ph == 10 ? 1 : ph == 13 ? 2 : 3;
                    g = pg8::Gemm{HID, (const bf16_t*)(ws + WS_WD + (size_t)wi * SZ_WD), ph == 21 ? MLAT : MTOT, DM, DFF};
                    ch = (ph == 3 || ph == 13) ? 2 : 8;
                    if (ph == 3) { E.rs.res_lat = P.in[0]; E.rs.res_ctx = P.in[2]; }
                    if (ph == 21) { E.rs.out_lat = P.out; E.rs.out_ctx = P.out; }
                }
                E.rs.gate = modl + (size_t)ch * DM;
            } else if (kind == 6) {
                g = pg8::Gemm{(const bf16_t*)(ws + WS_Z), (const bf16_t*)(ws + WS_W12), MTOT, 4096, DM}; E.mode = 2;
            } else {
                g = pg8::Gemm{Abuf, (const bf16_t*)(ws + WS_WQKV), MTOT, NQKV, DM}; E.mode = 3;
            }
            pg8::StaticOrder S; S.init(g.M, g.N, G, obid());
            pg8::gemm_phase((LAS unsigned char*)lds, g, S, E, E.mode == 0);
        }
        else if (kind == 4) { s5_phase(P, lds); }
        else if (kind == 5) { s5_merge_phase(P); }
        else if (kind == 8) { qknorm_phase(P); }
        else { attn_phase(P, lds); }
    }
}

extern "C" void kernel_launch(void* const* d_in, const int* in_sizes, int n_in, void* d_out, int out_size, void* d_ws, size_t ws_size, hipStream_t stream) {
    static int grid = 0;
    if (grid == 0) {
        if (n_in != 29 || ws_size < WS_END) { fprintf(stderr, "kernel_launch: unexpected n_in %d or ws_size %zu (< %zu)\n", n_in, ws_size, (size_t)WS_END); grid = -1; return; }
        int dev = 0, cus = 0, per_cu = 0;
        hipGetDevice(&dev);
        hipDeviceGetAttribute(&cus, hipDeviceAttributeMultiprocessorCount, dev);
        if (hipFuncSetAttribute((const void*)fwd_kernel, hipFuncAttributeMaxDynamicSharedMemorySize, LDS_BYTES) != hipSuccess) { fprintf(stderr, "kernel_launch: hipFuncSetAttribute failed\n"); grid = -1; return; }
        if (hipOccupancyMaxActiveBlocksPerMultiprocessor(&per_cu, (const void*)fwd_kernel, 512, LDS_BYTES) != hipSuccess || per_cu < 1) { fprintf(stderr, "kernel_launch: occupancy query says %d\n", per_cu); per_cu = 1; }
        (void)hipGetLastError();
        grid = cus * 1;
    }
    if (grid < 0) return;
    Params p{};
    for (int i = 0; i < 29; ++i) p.in[i] = (const float*)d_in[i];
    p.out = (float*)d_out; p.ws = (unsigned char*)d_ws;
#if MULTI_LAUNCH
    for (int ph = 0; ph < NPHASE; ++ph) {
        p.ph_lo = ph; p.ph_hi = ph + 1;
        hipLaunchKernelGGL(fwd_kernel, dim3(grid), dim3(512), LDS_BYTES, stream, p);
    }
#else
    p.ph_lo = 0; p.ph_hi = NPHASE;
    void* args[] = {&p};
    hipError_t e = hipLaunchCooperativeKernel((const void*)fwd_kernel, dim3(grid), dim3(512), args, LDS_BYTES, stream);
    if (e != hipSuccess) fprintf(stderr, "cooperative launch failed: %s (grid %d)\n", hipGetErrorString(e), grid);
#endif
}
```

```cpp
#include <hip/hip_runtime.h>
#include <hip/hip_cooperative_groups.h>
#include <cstdio>
#include <cstdint>
namespace cg = cooperative_groups;

#ifndef PROBE_GROUP
#define PROBE_GROUP -1
#endif
#ifndef MULTI_LAUNCH
#define MULTI_LAUNCH 0
#endif

typedef unsigned short bf16_t;
typedef short bf16x8 __attribute__((ext_vector_type(8)));
typedef short s16x4 __attribute__((ext_vector_type(4)));
typedef float f32x2 __attribute__((ext_vector_type(2)));
typedef float f32x4 __attribute__((ext_vector_type(4)));
typedef float f32x16 __attribute__((ext_vector_type(16)));
typedef unsigned u32x2 __attribute__((ext_vector_type(2)));
typedef unsigned u32x4 __attribute__((ext_vector_type(4)));
#define LAS __attribute__((address_space(3)))

constexpr int DM = 2048, NBATCH = 4, SEQ = 2048, CTXL = 256, DFF = 5632, NMODC = 9 * DM  ;
constexpr int MLAT = NBATCH * SEQ  , MCTX = NBATCH * CTXL  , MTOT = MLAT + MCTX  ;
constexpr int TKV = CTXL + SEQ  ;
constexpr int NQKV = 3072, KVD = 512;
constexpr int NPHASE = 25;
constexpr int LDS_MAIN = 131072, LDS_BYTES = LDS_MAIN + 64;

constexpr size_t SZ_WGU = (size_t)2 * DFF * DM * 2, SZ_WD = (size_t)DM * DFF * 2;
constexpr size_t WS_WGU = 0;
constexpr size_t WS_WD = WS_WGU + 4 * SZ_WGU;
constexpr size_t WS_W12 = WS_WD + 4 * SZ_WD;
constexpr size_t WS_WQKV = WS_W12 + (size_t)4096 * DM * 2;
constexpr size_t WS_WO = WS_WQKV + (size_t)NQKV * DM * 2;
constexpr size_t WS_MOD = WS_WO + (size_t)DM * DM * 2;
constexpr size_t WS_H = WS_MOD + (size_t)2 * 5 * NMODC * 4;
constexpr size_t WS_A = WS_H + (size_t)MTOT * DM * 4;
constexpr size_t WS_HID = WS_A + (size_t)MTOT * DM * 2;
constexpr size_t WS_YF = WS_HID + (size_t)MTOT * DFF * 2;
constexpr size_t WS_YB = WS_YF + (size_t)MTOT * DM * 4;
constexpr size_t WS_Z = WS_YB + (size_t)MTOT * DM * 4;
constexpr size_t WS_QKV = WS_Z + (size_t)MTOT * DM * 2;
constexpr size_t WS_QB = WS_QKV + (size_t)MTOT * NQKV * 4;
constexpr size_t WS_KB = WS_QB + (size_t)MLAT * DM * 2;
constexpr size_t WS_VB = WS_KB + (size_t)NBATCH * TKV * KVD * 2;
constexpr size_t WS_OB = WS_VB + (size_t)NBATCH * TKV * KVD * 2;
constexpr size_t WS_BAR = WS_OB + (size_t)MLAT * DM * 2;
constexpr size_t WS_END = WS_BAR + 16384;

struct Params {
    const float* in[29];
    float* out;
    unsigned char* ws;
    int ph_lo, ph_hi;
};

__device__ __forceinline__ unsigned cvt_pk_bf16(float lo, float hi) { unsigned r; asm volatile("v_cvt_pk_bf16_f32 %0, %1, %2" : "=v"(r) : "v"(lo), "v"(hi)); return r; }
__device__ __forceinline__ float fast_rcp(float x) { return __builtin_amdgcn_rcpf(x); }
__device__ __forceinline__ float sigmoidf_(float x) { return fast_rcp(1.f + __expf(-x)); }
__device__ __forceinline__ float siluf_(float x) { return x * sigmoidf_(x); }
__device__ __forceinline__ float gelu_tanh(float x) { const float y = 0.7978845608028654f * (x + 0.044715f * x * x * x); return x * sigmoidf_(2.f * y); }
__device__ __forceinline__ float wave_sum(float v) {
#pragma unroll
    for (int o = 32; o > 0; o >>= 1) v += __shfl_xor(v, o, 64);
    return v;
}
__device__ __forceinline__ int otid() { int t = threadIdx.x; asm volatile("" : "+v"(t)); return t; }
__device__ __forceinline__ int obid() { int b = blockIdx.x; asm volatile("" : "+s"(b)); return b; }
#define WAVE_LDS_SYNC() asm volatile("s_waitcnt lgkmcnt(0)" ::: "memory")


#define XB_TMO      128
#define XB_XCNT(j)  (256  + 64 * (j))
#define XB_XSUB(j)  (1280 + 64 * (j))
#define XB_XGEN(j)  (2304 + 64 * (j))
#define XB_TOP      3328
#define XB_TOPGEN   3392
#define XCD_BAR_WORDS 3456
#define XB_SPIN_CAP (1u << 22)
__device__ __forceinline__ unsigned xb_ld(unsigned* p)              { return __hip_atomic_load(p, __ATOMIC_RELAXED, __HIP_MEMORY_SCOPE_AGENT); }
__device__ __forceinline__ unsigned xb_add(unsigned* p, unsigned v) { return __hip_atomic_fetch_add(p, v, __ATOMIC_RELAXED, __HIP_MEMORY_SCOPE_AGENT); }
__device__ __forceinline__ unsigned xb_xcc_id() { return (unsigned)__builtin_amdgcn_s_getreg((3 << 11) | 20) & 0xFu; }
#define XB_SPIN(cond, bar) do { unsigned _sp = 0; while (cond) { __builtin_amdgcn_s_sleep(1); \
    if ((++_sp & 255u) == 0u) { if (xb_ld(&(bar)[XB_TMO])) break; if (_sp > XB_SPIN_CAP) { atomicAdd(&(bar)[XB_TMO], 1u); break; } } } } while (0)
struct XcdBarrier { unsigned* bar; unsigned x; volatile LAS unsigned* st; };
__device__ __forceinline__ XcdBarrier xcd_barrier_post(unsigned* bar, volatile LAS unsigned* st) {
    XcdBarrier b; b.bar = bar; b.x = xb_xcc_id(); b.st = st;
    if (threadIdx.x == 0) (void)xb_add(&bar[XB_XCNT(b.x)], 1u);
    return b;
}
__device__ __forceinline__ void xcd_barrier_complete(unsigned* bar, unsigned x, unsigned& nloc, unsigned& nx) {
    const unsigned G = gridDim.x * gridDim.y * gridDim.z;
    unsigned sum, cnt, mine, sp = 0u;
    for (;;) {
        sum = 0u; cnt = 0u; mine = 0u;
#pragma unroll
        for (unsigned j = 0; j < 16; ++j) { const unsigned c = xb_ld(&bar[XB_XCNT(j)]); sum += c; cnt += (c > 0u) ? 1u : 0u; mine = (j == x) ? c : mine; }
        if (sum == G) break;
        __builtin_amdgcn_s_sleep(1);
        if ((++sp & 255u) == 0u) { if (xb_ld(&bar[XB_TMO])) break; if (sp > XB_SPIN_CAP) { atomicAdd(&bar[XB_TMO], 1u); break; } }
    }
    nloc = mine > 0u ? mine : 1u; nx = cnt > 0u ? cnt : 1u;
}
__device__ __forceinline__ void xcd_barrier(const XcdBarrier& b) {
    asm volatile("s_waitcnt vmcnt(0)" ::: "memory");
    __syncthreads();
    if (threadIdx.x == 0) {
        unsigned* bar = b.bar;
        __builtin_amdgcn_s_waitcnt(0);
        unsigned nloc = b.st[0], nx = b.st[1];
        if (nloc == 0u) { xcd_barrier_complete(bar, b.x, nloc, nx); b.st[0] = nloc; b.st[1] = nx; }
        const unsigned old = xb_add(&bar[XB_XSUB(b.x)], 1u);
        const unsigned gen = old / nloc;
        if (old + 1u == (gen + 1u) * nloc) {
            __builtin_amdgcn_fence(__ATOMIC_RELEASE, "agent");
            asm volatile("s_waitcnt vmcnt(0)" ::: "memory");
            const unsigned og = xb_add(&bar[XB_TOP], 1u);
            const unsigned tg = og / nx;
            if (og + 1u == (tg + 1u) * nx) xb_add(&bar[XB_TOPGEN], 1u);
            else XB_SPIN(xb_ld(&bar[XB_TOPGEN]) == tg, bar);
            __builtin_amdgcn_fence(__ATOMIC_ACQUIRE, "agent");
            xb_add(&bar[XB_XGEN(b.x)], 1u);
            asm volatile("s_waitcnt vmcnt(0)" ::: "memory");
        } else {
            XB_SPIN(xb_ld(&bar[XB_XGEN(b.x)]) == gen, bar);
            __builtin_amdgcn_fence(__ATOMIC_ACQUIRE, "agent");
            asm volatile("s_waitcnt vmcnt(0)" ::: "memory");
        }
    }
    __syncthreads();
}

namespace pg8 {
constexpr int BM = 256, BK = 64, HALF = 128, HTB = HALF * BK * 2, STAGE_BYTES = 8 * HTB, NXCD = 8, WGM = 8;
__host__ __device__ __forceinline__ int lds_byte(int r, int c) { const int st = (r >> 4) * 2 + (c >> 5), rr = r & 15, cc = c & 31, ob = rr * 64 + cc * 2; return st * 1024 + (ob ^ (((ob >> 9) & 1) << 5)); }
__host__ __device__ __forceinline__ void stage_rc(int b, int& R, int& C) { const int st = b / 1024, sb = b % 1024, swz = sb ^ (((sb >> 9) & 1) << 5); R = (st >> 1) * 16 + swz / 64; C = (st & 1) * 32 + (swz % 64) / 2; }
__host__ __device__ __forceinline__ int perm32(int rho) { const int n = rho >> 4, i = rho & 15; return 8 * (i >> 2) + 4 * n + (i & 3); }
struct Unit { int pm, pn; };
struct Gemm { const bf16_t* A; const bf16_t* Bt; int M, N, K; };
struct StaticOrder {
    int nM, nN, nwg, G, c;
    int mode, cp, spm, spn;
    __device__ void init(int M, int N, int G_, int c_) { nM = M / BM; nN = N / BM; nwg = nM * nN; G = G_; c = c_; mode = 0; cp = (c_ & 7) * 32 + (c_ >> 3); spm = 0; spn = 0; }
    __device__ bool next(int i, Unit& u) const {
        if (mode == 0) {
            const long L = (long)i * G + c; if (L >= nwg) return false;
            int wgid = (int)L; { const int q = nwg / NXCD, r = nwg % NXCD, xcd = wgid % NXCD, off = wgid / NXCD; wgid = (xcd < r ? xcd * (q + 1) : r * (q + 1) + (xcd - r) * q) + off; }
            const int nig = WGM * nN, gid = wgid / nig, fm = gid * WGM, gsz = (nM - fm) < WGM ? (nM - fm) : WGM;
            u.pm = fm + ((wgid % nig) % gsz); u.pn = (wgid % nig) / gsz; return true;
        }
        if (mode == 4) return false;
        if (mode == 3) { if (i) return false; u.pm = spm; u.pn = spn; return true; }
        int ell;
        if (mode == 1) { if (i) return false; if (cp < 176) { u.pm = 32 + (cp & 3); u.pn = cp >> 2; return true; } ell = 1328 + cp - 176; }
        else { if (i < 3) ell = cp + 256 * i; else { if (cp >= 224) return false; ell = 768 + cp + 224 * (i - 3); if (ell >= 1328) return false; } }
        const int bl = ell >> 5, q = ell & 31; u.pm = (bl & 3) * 8 + (q & 7); u.pn = (bl >> 2) * 4 + (q >> 3); return true;
    }
};

struct EpiAny;
__device__ __forceinline__ void epi_any(const EpiAny& E, const f32x4 (&acc)[2][2][4][2], const Unit& u, int wr, int wc, int fr, int fq);
__device__ __forceinline__ void gemm_phase(LAS unsigned char* lds, const Gemm g, const StaticOrder& S, const EpiAny& E, const bool PERMB) {
    const int tid = otid(), wid = __builtin_amdgcn_readfirstlane(tid >> 6), lane = tid & 63, wr = wid >> 2, wc = wid & 3, fr = lane & 15, fq = lane >> 4;
    const int K = g.K, nt = K / BK;
    unsigned voffA[2], voffB[2];
#pragma unroll
    for (int i = 0; i < 2; ++i) { int R, C; stage_rc(tid * 16 + i * 8192, R, C); const int Rb = PERMB ? ((R & ~31) + perm32(R & 31)) : R;
        voffA[i] = (unsigned)(R * K + C) * 2u; voffB[i] = (unsigned)(Rb * K + C) * 2u; }
    const size_t kstep = (size_t)(BK * 2);
    const size_t hstep = (size_t)HALF * K * 2;
    const size_t tstep = 2 * hstep;
    const unsigned ldsw = (unsigned)wid * 1024u;
    const int aoff = lds_byte(wr * 64 + fr, fq * 8), boff = lds_byte(wc * 32 + fr, fq * 8);
#define PG8_SA(b, h) (((b) * 2 + (h)) * HTB)
#define PG8_SB(b, h) ((4 + (b) * 2 + (h)) * HTB)
#define PG8_STAGE(bufoff, gbase, voff) do { _Pragma("unroll") for (int _i = 0; _i < 2; ++_i) \
        __builtin_amdgcn_global_load_lds((const unsigned*)((const char*)(gbase) + (voff)[_i]), (LAS unsigned*)(lds + (bufoff) + ldsw + _i * 8192), 16, 0, 0); } while (0)
#define PG8_LDA(dst, b, h) do { _Pragma("unroll") for (int m = 0; m < 4; ++m) _Pragma("unroll") for (int k = 0; k < 2; ++k) dst[m][k] = *(const LAS bf16x8*)(lds + PG8_SA(b, h) + aoff + m * 2048 + k * 1024); } while (0)
#define PG8_LDB(dst, b, h) do { _Pragma("unroll") for (int n = 0; n < 2; ++n) _Pragma("unroll") for (int k = 0; k < 2; ++k) dst[n][k] = *(const LAS bf16x8*)(lds + PG8_SB(b, h) + boff + n * 2048 + k * 1024); } while (0)
#define PG8_MMA(ai, bj, At, Bt) do { __builtin_amdgcn_s_setprio(1); _Pragma("unroll") for (int m = 0; m < 4; ++m) _Pragma("unroll") for (int n = 0; n < 2; ++n) _Pragma("unroll") for (int k = 0; k < 2; ++k) \
        acc[ai][bj][m][n] = __builtin_amdgcn_mfma_f32_16x16x32_bf16(Bt[n][k], At[m][k], acc[ai][bj][m][n], 0, 0, 0); __builtin_amdgcn_s_setprio(0); } while (0)
#define PG8_WAIT_V(n) asm volatile("s_waitcnt vmcnt(" #n ")" ::: "memory")
#define PG8_WAIT_L(n) asm volatile("s_waitcnt lgkmcnt(" #n ")" ::: "memory")
#define PG8_BAR __builtin_amdgcn_s_barrier()
#define PG8_SCHED __builtin_amdgcn_sched_barrier(0)
    Unit cur, nxt; int ui = 0;
    if (!S.next(0, cur)) return;
    f32x4 acc[2][2][4][2];
#pragma unroll
    for (int a = 0; a < 2; ++a)
#pragma unroll
        for (int b = 0; b < 2; ++b)
#pragma unroll
            for (int m = 0; m < 4; ++m)
#pragma unroll
                for (int n = 0; n < 2; ++n) acc[a][b][m][n] = (f32x4){0.f, 0.f, 0.f, 0.f};
    bf16x8 At[4][2], B0[2][2], B1[2][2];
    const char* cA = (const char*)g.A + (size_t)cur.pm * tstep; const char* cB = (const char*)g.Bt + (size_t)cur.pn * tstep;
    PG8_STAGE(PG8_SB(0, 0), cB, voffB); PG8_STAGE(PG8_SA(0, 0), cA, voffA); PG8_STAGE(PG8_SB(0, 1), cB + hstep, voffB); PG8_STAGE(PG8_SA(0, 1), cA + hstep, voffA);
    if (wr == 1) PG8_BAR;
    PG8_WAIT_V(4); PG8_BAR;
    PG8_STAGE(PG8_SB(1, 0), cB + kstep, voffB); PG8_STAGE(PG8_SA(1, 0), cA + kstep, voffA); PG8_STAGE(PG8_SB(1, 1), cB + hstep + kstep, voffB);
    PG8_WAIT_V(6); PG8_BAR;
    for (;;) {
        const bool has_next = S.next(ui + 1, nxt);
        const char* nA = has_next ? (const char*)g.A + (size_t)nxt.pm * tstep : cA; const char* nB = has_next ? (const char*)g.Bt + (size_t)nxt.pn * tstep : cB;
        for (int t = 0; t < nt; t += 2) {
            const bool last = (t == nt - 2);
            const char* a1 = cA + (size_t)(t + 1) * kstep;
            const char* a2 = last ? nA : cA + (size_t)(t + 2) * kstep; const char* b2 = last ? nB : cB + (size_t)(t + 2) * kstep;
            const char* a3 = a2 + kstep; const char* b3 = b2 + kstep;
            PG8_LDB(B0, 0, 0); PG8_SCHED; PG8_LDA(At, 0, 0); PG8_STAGE(PG8_SA(1, 1), a1 + hstep, voffA);
            PG8_WAIT_L(8); PG8_BAR; PG8_WAIT_L(0); PG8_MMA(0, 0, At, B0); PG8_BAR; PG8_SCHED;
            PG8_LDB(B1, 0, 1); PG8_STAGE(PG8_SB(0, 0), b2, voffB);
            PG8_BAR; PG8_WAIT_L(0); PG8_MMA(0, 1, At, B1); PG8_BAR;
            PG8_LDA(At, 0, 1); PG8_STAGE(PG8_SA(0, 0), a2, voffA);
            PG8_BAR; PG8_WAIT_L(0); PG8_MMA(1, 0, At, B0); PG8_BAR; PG8_SCHED;
            PG8_STAGE(PG8_SB(0, 1), b2 + hstep, voffB);
            PG8_WAIT_V(6); PG8_BAR; PG8_MMA(1, 1, At, B1); PG8_BAR;
            PG8_LDB(B0, 1, 0); PG8_SCHED; PG8_LDA(At, 1, 0); PG8_STAGE(PG8_SA(0, 1), a2 + hstep, voffA);
            PG8_WAIT_L(8); PG8_BAR; PG8_WAIT_L(0); PG8_MMA(0, 0, At, B0); PG8_BAR; PG8_SCHED;
            PG8_LDB(B1, 1, 1); PG8_STAGE(PG8_SB(1, 0), b3, voffB);
            PG8_BAR; PG8_WAIT_L(0); PG8_MMA(0, 1, At, B1); PG8_BAR;
            PG8_LDA(At, 1, 1); PG8_STAGE(PG8_SA(1, 0), a3, voffA);
            PG8_BAR; PG8_WAIT_L(0); PG8_MMA(1, 0, At, B0); PG8_BAR; PG8_SCHED;
            PG8_STAGE(PG8_SB(1, 1), b3 + hstep, voffB);
            PG8_WAIT_V(6); PG8_BAR; PG8_MMA(1, 1, At, B1); PG8_BAR;
        }
        epi_any(E, acc, cur, wr, wc, fr, fq);
        if (!has_next) break;
#pragma unroll
        for (int a = 0; a < 2; ++a)
#pragma unroll
            for (int b = 0; b < 2; ++b)
#pragma unroll
                for (int m = 0; m < 4; ++m)
#pragma unroll
                    for (int n = 0; n < 2; ++n) acc[a][b][m][n] = (f32x4){0.f, 0.f, 0.f, 0.f};
        cur = nxt; cA = nA; cB = nB; ++ui;
    }
    PG8_WAIT_V(0);
    if (wr == 0) PG8_BAR;
    PG8_BAR;
#undef PG8_SA
#undef PG8_SB
#undef PG8_STAGE
#undef PG8_LDA
#undef PG8_LDB
#undef PG8_MMA
#undef PG8_WAIT_V
#undef PG8_WAIT_L
#undef PG8_BAR
#undef PG8_SCHED
}

struct EpiSwiglu {
    static constexpr bool PERM = true;
    bf16_t* O; int ldo;
    __device__ __forceinline__ void operator()(const f32x4 (&acc)[2][2][4][2], const Unit& u, int wr, int wc, int fr, int fq) const {
        const int row0 = u.pm * BM + wr * 64 + fr, col0 = u.pn * HALF + wc * 32 + 8 * fq;
#pragma unroll
        for (int ai = 0; ai < 2; ++ai)
#pragma unroll
            for (int m = 0; m < 4; ++m) {
                bf16_t* rowp = O + (size_t)(row0 + ai * HALF + m * 16) * ldo + col0;
                float v[8];
#pragma unroll
                for (int n = 0; n < 2; ++n)
#pragma unroll
                    for (int j = 0; j < 4; ++j) { const float gt = acc[ai][0][m][n][j], up = acc[ai][1][m][n][j]; v[n * 4 + j] = siluf_(gt) * up; }
                u32x4 w; w.x = cvt_pk_bf16(v[0], v[1]); w.y = cvt_pk_bf16(v[2], v[3]); w.z = cvt_pk_bf16(v[4], v[5]); w.w = cvt_pk_bf16(v[6], v[7]);
                *(u32x4*)rowp = w;
            }
    }
};
struct EpiResid {
    static constexpr bool PERM = false;
    const float* res_lat; const float* res_ctx; float* out_lat; float* out_ctx; const float* gate; float coef;
    __device__ __forceinline__ void operator()(const f32x4 (&acc)[2][2][4][2], const Unit& u, int wr, int wc, int fr, int fq) const {
        const int row0 = u.pm * BM + wr * 64 + fr, col0 = u.pn * BM + wc * 32 + 4 * fq;
        const bool isl = u.pm < MLAT / BM; const int mrow = isl ? (u.pm >> 3) : 4;
        const float* rb = isl ? res_lat : res_ctx - (size_t)MLAT * DM; float* ob = isl ? out_lat : out_ctx - (size_t)MLAT * DM;
        const float* gp = gate + (size_t)mrow * NMODC;
#pragma unroll
        for (int bj = 0; bj < 2; ++bj) {
            f32x4 gv[2];
#pragma unroll
            for (int n = 0; n < 2; ++n) gv[n] = *(const f32x4*)(gp + col0 + bj * HALF + n * 16);
#pragma unroll
            for (int ai = 0; ai < 2; ++ai) {
                f32x4 r[4][2];
#pragma unroll
                for (int m = 0; m < 4; ++m) { const size_t ro = (size_t)(row0 + ai * HALF + m * 16) * DM + col0 + bj * HALF;
#pragma unroll
                    for (int n = 0; n < 2; ++n) r[m][n] = *(const f32x4*)(rb + ro + n * 16); }
#pragma unroll
                for (int m = 0; m < 4; ++m) { const size_t ro = (size_t)(row0 + ai * HALF + m * 16) * DM + col0 + bj * HALF;
#pragma unroll
                    for (int n = 0; n < 2; ++n) *(f32x4*)(ob + ro + n * 16) = r[m][n] + (gv[n] * coef) * acc[ai][bj][m][n]; }
            }
        }
    }
};
struct EpiGlu {
    static constexpr bool PERM = false;
    float* h; const float* gate;
    __device__ __forceinline__ void operator()(const f32x4 (&acc)[2][2][4][2], const Unit& u, int wr, int wc, int fr, int fq) const {
        const int row0 = u.pm * BM + wr * 64 + fr, col0 = u.pn * HALF + wc * 32 + 4 * fq;
        const int mrow = u.pm < MLAT / BM ? (u.pm >> 3) : 4;
        const float* gp = gate + (size_t)mrow * NMODC;
        f32x4 gv[2];
#pragma unroll
        for (int n = 0; n < 2; ++n) gv[n] = *(const f32x4*)(gp + col0 + n * 16);
#pragma unroll
        for (int ai = 0; ai < 2; ++ai) {
            f32x4 r[4][2];
#pragma unroll
            for (int m = 0; m < 4; ++m) { const float* rowp = h + (size_t)(row0 + ai * HALF + m * 16) * DM + col0;
#pragma unroll
                for (int n = 0; n < 2; ++n) r[m][n] = *(const f32x4*)(rowp + n * 16); }
#pragma unroll
            for (int m = 0; m < 4; ++m) { float* rowp = h + (size_t)(row0 + ai * HALF + m * 16) * DM + col0;
#pragma unroll
                for (int n = 0; n < 2; ++n) { f32x4 o = r[m][n]; const f32x4 a1 = acc[ai][0][m][n], a2 = acc[ai][1][m][n];
#pragma unroll
                    for (int j = 0; j < 4; ++j) o[j] += gv[n][j] * a1[j] * sigmoidf_(a2[j]);
                    *(f32x4*)(rowp + n * 16) = o; } }
        }
    }
};
struct EpiF32 {
    static constexpr bool PERM = false;
    float* C; int ldc; bf16_t* VB;
    __device__ __forceinline__ void operator()(const f32x4 (&acc)[2][2][4][2], const Unit& u, int wr, int wc, int fr, int fq) const {
        const int row0 = u.pm * BM + wr * 64 + fr, col0 = u.pn * BM + wc * 32 + 4 * fq;
        if (u.pm >= MLAT / BM && u.pn < 8) return;
        if (u.pn >= 10) {
            const int kv0 = u.pm < MLAT / BM ? (u.pm >> 3) * TKV + CTXL + ((u.pm & 7) * BM) : (u.pm - MLAT / BM) * TKV;
            const int vc0 = (u.pn - 10) * BM + wc * 32 + 4 * fq;
#pragma unroll
            for (int ai = 0; ai < 2; ++ai)
#pragma unroll
                for (int m = 0; m < 4; ++m) { bf16_t* rowp = VB + (size_t)(kv0 + wr * 64 + fr + ai * HALF + m * 16) * KVD + vc0;
#pragma unroll
                    for (int bj = 0; bj < 2; ++bj)
#pragma unroll
                        for (int n = 0; n < 2; ++n) { const f32x4 a = acc[ai][bj][m][n]; u32x2 pk; pk.x = cvt_pk_bf16(a[0], a[1]); pk.y = cvt_pk_bf16(a[2], a[3]); *(u32x2*)(rowp + bj * HALF + n * 16) = pk; } }
            return;
        }
#pragma unroll
        for (int ai = 0; ai < 2; ++ai)
#pragma unroll
            for (int m = 0; m < 4; ++m) { float* rowp = C + (size_t)(row0 + ai * HALF + m * 16) * ldc + col0;
#pragma unroll
                for (int bj = 0; bj < 2; ++bj)
#pragma unroll
                    for (int n = 0; n < 2; ++n) *(f32x4*)(rowp + bj * HALF + n * 16) = acc[ai][bj][m][n]; }
    }
};
struct EpiAny { int mode; EpiSwiglu sw; EpiResid rs; EpiGlu gl; EpiF32 f3; };
__device__ __forceinline__ void epi_any(const EpiAny& E, const f32x4 (&acc)[2][2][4][2], const Unit& u, int wr, int wc, int fr, int fq) {
    if (E.mode == 0) E.sw(acc, u, wr, wc, fr, fq);
    else if (E.mode == 1) E.rs(acc, u, wr, wc, fr, fq);
    else if (E.mode == 2) E.gl(acc, u, wr, wc, fr, fq);
    else E.f3(acc, u, wr, wc, fr, fq);
}
}

__device__ __forceinline__ void transpose_item(const Params& P, int t, int lane, int wbase, int wstep) {
    const float* src; bf16_t* dst; int K, N, nb, kb, pair;
    if (t < 8448) {
        const int q = t / 704, r = t % 704, lf = q / 3, kind = q % 3, l = lf >> 1, f = lf & 1;
        if (kind < 2) { K = DM; N = DFF; nb = r >> 3; kb = r & 7; src = P.in[9 + f * 3 + kind] + (size_t)l * DM * DFF; dst = (bf16_t*)(P.ws + WS_WGU + (size_t)lf * SZ_WGU); pair = 1 + kind; }
        else { K = DFF; N = DM; nb = r / 22; kb = r % 22; src = P.in[11 + f * 3] + (size_t)l * DM * DFF; dst = (bf16_t*)(P.ws + WS_WD + (size_t)lf * SZ_WD); pair = 0; }
    } else {
        const int r = t - 8448;
        if (r < 512) { K = DM; N = DM; nb = (r & 255) >> 3; kb = r & 7; src = P.in[r < 256 ? 23 : 24]; dst = (bf16_t*)(P.ws + WS_W12); pair = r < 256 ? 1 : 2; }
        else if (r < 896) { const int r2 = r - 512; K = DM; N = NQKV; nb = r2 >> 3; kb = r2 & 7; src = P.in[25]; dst = (bf16_t*)(P.ws + WS_WQKV); pair = 0; }
        else { const int r2 = r - 896; K = DM; N = DM; nb = r2 >> 3; kb = r2 & 7; src = P.in[26]; dst = (bf16_t*)(P.ws + WS_WO); pair = 0; }
    }
    const int n = nb * 64 + lane;
    const int nr = pair == 0 ? n : ((n >> 7) * 256 + (pair - 1) * 128 + (n & 127));
    if (wstep == 8) {
        const int k0 = kb * 256 + wbase * 32;
        const float* sp = src + (size_t)k0 * N + n;
        float v[32];
#pragma unroll
        for (int j = 0; j < 32; ++j) v[j] = __builtin_nontemporal_load(sp + (size_t)j * N);
        bf16_t* dp = dst + (size_t)nr * K + k0;
#pragma unroll
        for (int cblk = 0; cblk < 4; ++cblk) { u32x4 o; o.x = cvt_pk_bf16(v[cblk * 8 + 0], v[cblk * 8 + 1]); o.y = cvt_pk_bf16(v[cblk * 8 + 2], v[cblk * 8 + 3]); o.z = cvt_pk_bf16(v[cblk * 8 + 4], v[cblk * 8 + 5]); o.w = cvt_pk_bf16(v[cblk * 8 + 6], v[cblk * 8 + 7]);
            *(u32x4*)(dp + cblk * 8) = o; }
    } else {
        const int k0 = kb * 256 + wbase * 64;
        const float* sp = src + (size_t)k0 * N + n;
        float v[64];
#pragma unroll
        for (int j = 0; j < 64; ++j) v[j] = __builtin_nontemporal_load(sp + (size_t)j * N);
        bf16_t* dp = dst + (size_t)nr * K + k0;
#pragma unroll
        for (int cblk = 0; cblk < 8; ++cblk) { u32x4 o; o.x = cvt_pk_bf16(v[cblk * 8 + 0], v[cblk * 8 + 1]); o.y = cvt_pk_bf16(v[cblk * 8 + 2], v[cblk * 8 + 3]); o.z = cvt_pk_bf16(v[cblk * 8 + 4], v[cblk * 8 + 5]); o.w = cvt_pk_bf16(v[cblk * 8 + 6], v[cblk * 8 + 7]);
            *(u32x4*)(dp + cblk * 8) = o; }
    }
}

template <int NK> __device__ __forceinline__ void trn_load(const Params& P, int t, int lane, int wq, float (&v)[NK], bf16_t*& dp) {
    const float* src; bf16_t* dst; int K, N, nb, kb, pair;
    if (t < 8448) {
        const int q = t / 704, r = t % 704, lf = q / 3, kind = q % 3, l = lf >> 1, f = lf & 1;
        if (kind < 2) { K = DM; N = DFF; nb = r >> 3; kb = r & 7; src = P.in[9 + f * 3 + kind] + (size_t)l * DM * DFF; dst = (bf16_t*)(P.ws + WS_WGU + (size_t)lf * SZ_WGU); pair = 1 + kind; }
        else { K = DFF; N = DM; nb = r / 22; kb = r % 22; src = P.in[11 + f * 3] + (size_t)l * DM * DFF; dst = (bf16_t*)(P.ws + WS_WD + (size_t)lf * SZ_WD); pair = 0; }
    } else {
        const int r = t - 8448;
        if (r < 512) { K = DM; N = DM; nb = (r & 255) >> 3; kb = r & 7; src = P.in[r < 256 ? 23 : 24]; dst = (bf16_t*)(P.ws + WS_W12); pair = r < 256 ? 1 : 2; }
        else if (r < 896) { const int r2 = r - 512; K = DM; N = NQKV; nb = r2 >> 3; kb = r2 & 7; src = P.in[25]; dst = (bf16_t*)(P.ws + WS_WQKV); pair = 0; }
        else { const int r2 = r - 896; K = DM; N = DM; nb = r2 >> 3; kb = r2 & 7; src = P.in[26]; dst = (bf16_t*)(P.ws + WS_WO); pair = 0; }
    }
    const int n = nb * 64 + lane;
    const int nr = pair == 0 ? n : ((n >> 7) * 256 + (pair - 1) * 128 + (n & 127));
    const int k0 = kb * 256 + wq * NK;
    const float* sp = src + (size_t)k0 * N + n;
#pragma unroll
    for (int j = 0; j < NK; ++j) v[j] = __builtin_nontemporal_load(sp + (size_t)j * N);
    dp = dst + (size_t)nr * K + k0;
}
template <int NK> __device__ __forceinline__ void trn_store(const float (&v)[NK], bf16_t* dp) {
#pragma unroll
    for (int cblk = 0; cblk < NK / 8; ++cblk) { u32x4 o; o.x = cvt_pk_bf16(v[cblk * 8 + 0], v[cblk * 8 + 1]); o.y = cvt_pk_bf16(v[cblk * 8 + 2], v[cblk * 8 + 3]); o.z = cvt_pk_bf16(v[cblk * 8 + 4], v[cblk * 8 + 5]); o.w = cvt_pk_bf16(v[cblk * 8 + 6], v[cblk * 8 + 7]);
        *(u32x4*)(dp + cblk * 8) = o; }
}
constexpr int NDEFER = 2112, NIMMED = 3840, TAIL_UB = 8, TAIL_GLU = 6;
__device__ __forceinline__ int late_item(int q);
__device__ __forceinline__ int deferred_item(int d) { return late_item(d); }
__device__ __forceinline__ int imm_item(int i, int G) { return (G != 256 || i < 2112) ? i : i < 2624 ? 8448 + (i - 2112) : 3008 + (i - 2624); }
__device__ __forceinline__ int late_item(int q) { return q < 2112 ? 4224 + q : q < 2752 ? 8960 + (q - 2112) : 6336 + (q - 2752); }
__device__ __forceinline__ void convert_range(const Params& P, int list, int lo, int hi) {
    const int tid = otid(), lane = tid & 63, w = tid >> 6;
    float va[32], vb[32]; bf16_t* dpa = nullptr; bf16_t* dpb = nullptr;
    int i = lo;
    if (i < hi) trn_load<32>(P, list ? late_item(i) : 2112 + i, lane, w, va, dpa);
#pragma unroll 1
    for (; i < hi; i += 2) {
        const int i1 = i + 1, i2 = i + 2;
        if (i1 < hi) trn_load<32>(P, list ? late_item(i1) : 2112 + i1, lane, w, vb, dpb);
        trn_store<32>(va, dpa);
        if (i2 < hi) trn_load<32>(P, list ? late_item(i2) : 2112 + i2, lane, w, va, dpa);
        if (i1 < hi) trn_store<32>(vb, dpb);
    }
}

__device__ __forceinline__ void p0_phase(const Params& P, unsigned char* lds_raw) {
    const int tid = otid(), lane = tid & 63, w = tid >> 6;
    float* s_lds = (float*)lds_raw;
    float* red = s_lds + 5 * DM;
    const float* c = P.in[1]; const float* cc = P.in[3];
    for (int i = tid; i < 5 * DM; i += 512) { const int r = i >> 11, k = i & (DM - 1); const float v = r < 4 ? c[r * DM + k] : cc[k]; s_lds[i] = siluf_(v); }
    __syncthreads();
    const float* ada_w = P.in[4]; const float* ada_b = P.in[5];
    float* mod = (float*)(P.ws + WS_MOD);
    const int G = gridDim.x, bx = obid();
    for (int item = bx; item < 576; item += G) {
        const int l = item / 288, n0 = (item % 288) * 64;
        const float* wp = ada_w + ((size_t)l * DM + w * 256) * NMODC + n0 + lane;
        float a0 = 0.f, a1 = 0.f, a2 = 0.f, a3 = 0.f, a4 = 0.f;
        const float* sp = s_lds + w * 256;
#pragma unroll 1
        for (int k0 = 0; k0 < 256; k0 += 16) {
            float wv[16];
#pragma unroll
            for (int j = 0; j < 16; ++j) wv[j] = __builtin_nontemporal_load(wp + (size_t)(k0 + j) * NMODC);
#pragma unroll
            for (int j = 0; j < 16; ++j) { const int k = k0 + j; a0 += sp[k] * wv[j]; a1 += sp[DM + k] * wv[j]; a2 += sp[2 * DM + k] * wv[j]; a3 += sp[3 * DM + k] * wv[j]; a4 += sp[4 * DM + k] * wv[j]; }
        }
        red[(w * 5 + 0) * 64 + lane] = a0; red[(w * 5 + 1) * 64 + lane] = a1; red[(w * 5 + 2) * 64 + lane] = a2; red[(w * 5 + 3) * 64 + lane] = a3; red[(w * 5 + 4) * 64 + lane] = a4;
        __syncthreads();
        if (tid < 320) { const int r = tid >> 6; float s = ada_b[(size_t)l * NMODC + n0 + lane];
#pragma unroll
            for (int ww = 0; ww < 8; ++ww) s += red[(ww * 5 + r) * 64 + lane];
            mod[((size_t)l * 5 + r) * NMODC + n0 + lane] = s; }
        __syncthreads();
    }
    int t_lo, t_hi;
    if (G == 256) { if (bx < 64) { t_lo = 11 * bx; t_hi = t_lo + 11; } else { t_lo = 704 + (int)(((long)(bx - 64) * 3136) / 192); t_hi = 704 + (int)(((long)(bx - 63) * 3136) / 192); } }
    else { t_lo = (int)(((long)bx * 9600) / G); t_hi = (int)(((long)(bx + 1) * 9600) / G); }
    {
        float va[32], vb[32]; bf16_t* dpa = nullptr; bf16_t* dpb = nullptr;
        int i = t_lo;
        if (i < t_hi) trn_load<32>(P, imm_item(i, G), lane, w, va, dpa);
#pragma unroll 1
        for (; i < t_hi; i += 2) {
            const int i1 = i + 1, i2 = i + 2;
            if (i1 < t_hi) trn_load<32>(P, imm_item(i1, G), lane, w, vb, dpb);
            trn_store<32>(va, dpa);
            if (i2 < t_hi) trn_load<32>(P, imm_item(i2, G), lane, w, va, dpa);
            if (i1 < t_hi) trn_store<32>(vb, dpb);
        }
    }
}

__device__ __forceinline__ void normmod_phase(const float* src_lat, const float* src_ctx, int nrows, const float* gnorm, const float* modl, int ch_shift, int ch_scale, bf16_t* dst) {
    const int lane = otid() & 63, gw = obid() * 8 + (otid() >> 6);
    const int pr = gw >> 1, odd = gw & 1, nw = gridDim.x * 8;
    const int per2 = (2 * nrows + nw - 1) / nw, h1 = (per2 + 1) >> 1;
    int r0 = pr * per2 + (odd ? h1 : 0), r1 = r0 + (odd ? per2 - h1 : h1);
    if (r1 > nrows) r1 = nrows;
    if (r0 >= r1) return;
    f32x4 v[8], vn[8], wq[8], shq[8];
    { const float* sp = r0 < MLAT ? src_lat + (size_t)r0 * DM : src_ctx + (size_t)(r0 - MLAT) * DM;
#pragma unroll
      for (int i = 0; i < 8; ++i) v[i] = *(const f32x4*)(sp + (i * 64 + lane) * 4); }
    int cur_mrow = -1;
#pragma unroll 1
    for (int row = r0; row < r1; ++row) {
        const int nrow = row + 1;
        if (nrow < r1) { const float* sp = nrow < MLAT ? src_lat + (size_t)nrow * DM : src_ctx + (size_t)(nrow - MLAT) * DM;
#pragma unroll
            for (int i = 0; i < 8; ++i) vn[i] = *(const f32x4*)(sp + (i * 64 + lane) * 4); }
        const int mrow = row < MLAT ? (row >> 11) : 4;
        if (mrow != cur_mrow) {
            cur_mrow = mrow;
            const float* shp = modl + (size_t)mrow * NMODC + ch_shift * DM; const float* scp = modl + (size_t)mrow * NMODC + ch_scale * DM;
#pragma unroll
            for (int i = 0; i < 8; ++i) { const int d = (i * 64 + lane) * 4; const f32x4 g4 = *(const f32x4*)(gnorm + d), sc = *(const f32x4*)(scp + d); shq[i] = *(const f32x4*)(shp + d); wq[i] = g4 * (sc + 1.f); }
        }
        float ss = 0.f;
#pragma unroll
        for (int i = 0; i < 8; ++i) ss += v[i][0] * v[i][0] + v[i][1] * v[i][1] + v[i][2] * v[i][2] + v[i][3] * v[i][3];
        ss = wave_sum(ss);
        const float r = rsqrtf(ss * (1.f / DM) + 1e-6f);
        bf16_t* dp = dst + (size_t)row * DM;
#pragma unroll
        for (int i = 0; i < 8; ++i) { const int d = (i * 64 + lane) * 4;
            const f32x4 o = v[i] * r * wq[i] + shq[i];
            u32x2 pk; pk.x = cvt_pk_bf16(o[0], o[1]); pk.y = cvt_pk_bf16(o[2], o[3]); *(u32x2*)(dp + d) = pk; }
#pragma unroll
        for (int i = 0; i < 8; ++i) v[i] = vn[i];
    }
}

__device__ __forceinline__ int crow(int r, int hi) { return (r & 3) + 8 * (r >> 2) + 4 * hi; }
constexpr int S5_BU_STRIDE = 36  , S5_BU_BYTES = 128 * S5_BU_STRIDE * 4, S5_HS_STRIDE = 272, S5_HS_BYTES = 32 * S5_HS_STRIDE, S5_WAVE_BYTES = S5_BU_BYTES + S5_HS_BYTES;
__device__ __forceinline__ void s5_phase(const Params& P, unsigned char* lds_raw) {
    const int tid = otid(), lane = tid & 63, w = tid >> 6;
    if (w >= 4) {
        const int G = gridDim.x, wq = w - 4;
        if (G != 256) return;
        float va[64], vb[64]; bf16_t* dpa = nullptr; bf16_t* dpb = nullptr;
        int d = obid();
        if (d < NDEFER) trn_load<64>(P, deferred_item(d), lane, wq, va, dpa);
#pragma unroll 1
        for (; d < NDEFER; d += 2 * G) {
            const int d2 = d + G, d3 = d + 2 * G;
            if (d2 < NDEFER) trn_load<64>(P, deferred_item(d2), lane, wq, vb, dpb);
            trn_store<64>(va, dpa);
            if (d3 < NDEFER) trn_load<64>(P, deferred_item(d3), lane, wq, va, dpa);
            if (d2 < NDEFER) trn_store<64>(vb, dpb);
        }
        return;
    }
    float* bu = (float*)(lds_raw + w * S5_WAVE_BYTES);
    unsigned char* hs = lds_raw + w * S5_WAVE_BYTES + S5_BU_BYTES;
    const bf16_t* U = (const bf16_t*)(P.ws + WS_A);
    const float* a_re = P.in[15]; const float* a_im = P.in[16]; const float* log_dt = P.in[17];
    const float* b_re = P.in[18]; const float* b_im = P.in[19]; const float* c_re = P.in[20]; const float* c_im = P.in[21];
    const int l31 = lane & 31, hi = lane >> 5, l15 = lane & 15, q4 = lane >> 4;
    for (int item = obid() * 4 + w; item < 1024; item += gridDim.x * 4) {
        const int dir = item & 1, g = (item >> 1) & 127, b = item >> 8;
        const int base = dir * 128 + g;
        const float dt = expf(log_dt[base]);
        float lre, lim;
        { const float are = a_re[base * 64 + lane], aim = a_im[base * 64 + lane]; const float mag = expf(are * dt); float s, c; sincosf(aim * dt, &s, &c); lre = mag * c; lim = mag * s; }
        bf16x8 Bf[4];
#pragma unroll
        for (int nb = 0; nb < 4; ++nb) {
            const int q = (nb & 1) * 32 + l31, comp = nb >> 1;
            const float are = a_re[base * 64 + q], aim = a_im[base * 64 + q]; const float mag = expf(are * dt); float s, c; sincosf(aim * dt, &s, &c);
            const float nre = mag * c - 1.f, nim = mag * s, den = fast_rcp(are * are + aim * aim);
            const float cre = (nre * are + nim * aim) * den, cim = (nim * are - nre * aim) * den;
            const float* br = b_re + ((size_t)base * 64 + q) * 16 + 8 * hi; const float* bi = b_im + ((size_t)base * 64 + q) * 16 + 8 * hi;
            float o[8];
#pragma unroll
            for (int j = 0; j < 8; ++j) { const float xr = br[j], xi = bi[j]; o[j] = comp == 0 ? (cre * xr - cim * xi) : (cre * xi + cim * xr); }
            u32x4 pk; pk.x = cvt_pk_bf16(o[0], o[1]); pk.y = cvt_pk_bf16(o[2], o[3]); pk.z = cvt_pk_bf16(o[4], o[5]); pk.w = cvt_pk_bf16(o[6], o[7]);
            Bf[nb] = *(bf16x8*)&pk;
        }
        bf16x8 Cf[4];
#pragma unroll
        for (int kb = 0; kb < 4; ++kb) {
            float o[8];
#pragma unroll
            for (int j = 0; j < 8; ++j) { const int k = kb * 32 + 8 * q4 + j, p = k >> 1; const size_t ci = ((size_t)base * 16 + l15) * 64 + p; o[j] = (k & 1) ? -c_im[ci] : c_re[ci]; }
            u32x4 pk; pk.x = cvt_pk_bf16(o[0], o[1]); pk.y = cvt_pk_bf16(o[2], o[3]); pk.z = cvt_pk_bf16(o[4], o[5]); pk.w = cvt_pk_bf16(o[6], o[7]);
            Cf[kb] = *(bf16x8*)&pk;
        }
        float* Y = (float*)(P.ws + (dir ? WS_YB : WS_YF));
        float hre = 0.f, him = 0.f;
        auto rowof = [&](int blk, int t) -> int {
            const int tau = blk * 32 + t;
            if (tau < CTXL) return MLAT + b * CTXL + (dir ? (CTXL - 1 - tau) : tau);
            const int s = tau - CTXL; return b * SEQ + (dir ? (SEQ - 1 - s) : s);
        };
        const int sgn = dir ? -1 : 1; const long sd = (long)sgn * DM;
        bf16x8 afr = *(const bf16x8*)(U + (size_t)(rowof(0, 0) + sgn * l31) * DM + g * 16 + 8 * hi);
#pragma unroll 1
        for (int blk = 0; blk < 72; ++blk) {
            const bf16x8 acur = afr;
            const int rbase = rowof(blk, 0);
            if (blk + 1 < 72) afr = *(const bf16x8*)(U + (size_t)(rowof(blk + 1, 0) + sgn * l31) * DM + g * 16 + 8 * hi);
#pragma unroll
            for (int nb = 0; nb < 4; ++nb) {
                f32x16 acc = {};
                acc = __builtin_amdgcn_mfma_f32_32x32x16_bf16(acur, Bf[nb], acc, 0, 0, 0);
                float* colp = bu + (nb * 32 + l31) * S5_BU_STRIDE + 4 * hi;
#pragma unroll
                for (int k = 0; k < 4; ++k) *(f32x4*)(colp + 8 * k) = (f32x4){acc[4 * k], acc[4 * k + 1], acc[4 * k + 2], acc[4 * k + 3]};
            }
            WAVE_LDS_SYNC();
#pragma unroll
            for (int th = 0; th < 2; ++th) {
                f32x4 bre4[4], bim4[4];
#pragma unroll
                for (int q = 0; q < 4; ++q) { bre4[q] = *(const f32x4*)(bu + lane * S5_BU_STRIDE + th * 16 + 4 * q); bim4[q] = *(const f32x4*)(bu + (64 + lane) * S5_BU_STRIDE + th * 16 + 4 * q); }
#pragma unroll
                for (int t = 0; t < 16; ++t) {
                    const float nre = fmaf(lre, hre, fmaf(-lim, him, bre4[t >> 2][t & 3])), nim = fmaf(lre, him, fmaf(lim, hre, bim4[t >> 2][t & 3]));
                    hre = nre; him = nim;
                    *(unsigned*)(hs + (th * 16 + t) * S5_HS_STRIDE + lane * 4) = cvt_pk_bf16(hre, him);
                }
            }
            WAVE_LDS_SYNC();
            float* yp = Y + (size_t)(rbase + sgn * (q4 * 4)) * DM + g * 16 + l15;
#pragma unroll
            for (int tb = 0; tb < 2; ++tb) {
                f32x4 acc = {0.f, 0.f, 0.f, 0.f};
#pragma unroll
                for (int kb = 0; kb < 4; ++kb) { const bf16x8 a = *(const bf16x8*)(hs + (tb * 16 + l15) * S5_HS_STRIDE + kb * 64 + q4 * 16); acc = __builtin_amdgcn_mfma_f32_16x16x32_bf16(a, Cf[kb], acc, 0, 0, 0); }
#pragma unroll
                for (int j = 0; j < 4; ++j) yp[(long)(tb * 16 + j) * sd] = acc[j];
            }
            WAVE_LDS_SYNC();
        }
    }
}

__device__ __forceinline__ void s5_merge_phase(const Params& P) {
    const float* __restrict__ yf = (const float*)(P.ws + WS_YF); const float* __restrict__ yb = (const float*)(P.ws + WS_YB); const bf16_t* __restrict__ U = (const bf16_t*)(P.ws + WS_A); bf16_t* __restrict__ Z = (bf16_t*)(P.ws + WS_Z);
    const float* dsk = P.in[22];
    const size_t n4 = (size_t)MTOT * DM / 4, stride = (size_t)gridDim.x * 512;
    for (size_t i0 = (size_t)obid() * 512 + otid(); i0 < n4; i0 += 4 * stride) {
        f32x4 a[4], bq[4]; u32x2 uu[4];
#pragma unroll
        for (int k = 0; k < 4; ++k) { const size_t i = i0 + k * stride; if (i < n4) { a[k] = __builtin_nontemporal_load((const f32x4*)(yf + i * 4)); bq[k] = __builtin_nontemporal_load((const f32x4*)(yb + i * 4)); uu[k] = *(const u32x2*)(U + i * 4); } }
#pragma unroll
        for (int k = 0; k < 4; ++k) { const size_t i = i0 + k * stride; if (i < n4) {
            const f32x4 d4 = *(const f32x4*)(dsk + ((i * 4) & (DM - 1)));
            const float u0 = __uint_as_float(uu[k].x << 16), u1 = __uint_as_float(uu[k].x & 0xffff0000u), u2 = __uint_as_float(uu[k].y << 16), u3 = __uint_as_float(uu[k].y & 0xffff0000u);
            const float z0 = gelu_tanh(a[k][0] + bq[k][0] + d4[0] * u0), z1 = gelu_tanh(a[k][1] + bq[k][1] + d4[1] * u1), z2 = gelu_tanh(a[k][2] + bq[k][2] + d4[2] * u2), z3 = gelu_tanh(a[k][3] + bq[k][3] + d4[3] * u3);
            u32x2 o; o.x = cvt_pk_bf16(z0, z1); o.y = cvt_pk_bf16(z2, z3); *(u32x2*)(Z + i * 4) = o; } }
    }
}

__device__ __forceinline__ void qknorm_phase(const Params& P) {
    const float* QKV = (const float*)(P.ws + WS_QKV); bf16_t* QB = (bf16_t*)(P.ws + WS_QB); bf16_t* KB = (bf16_t*)(P.ws + WS_KB); bf16_t* VB = (bf16_t*)(P.ws + WS_VB);
    const float* qg = P.in[27]; const float* kg = P.in[28];
    const int lane = otid() & 63, gw = obid() * 8 + (otid() >> 6), nw = gridDim.x * 8;
    const int i31 = lane & 31, e1 = lane < 32 ? lane : 32 + lane, e2 = e1 + 32;
    const float freq = exp2f(-(float)i31 * (13.287712379549449f / 32.f));
    const float qg1 = qg[e1], qg2 = qg[e2], kg1 = kg[e1], kg2 = kg[e2];
    for (int row = gw; row < MTOT; row += nw) {
        const bool isl = row < MLAT;
        float cs = 1.f, sn = 0.f; int kvrow;
        if (isl) { const int b = row >> 11, s = row & (SEQ - 1); const int pos = lane < 32 ? (s >> 6) : (s & 63); sincosf((float)pos * freq, &sn, &cs); kvrow = b * TKV + CTXL + s; }
        else { const int r = row - MLAT, b = r >> 8, lidx = r & (CTXL - 1); kvrow = b * TKV + lidx; }
        const float* rp = QKV + (size_t)row * NQKV;
        float x1[20], x2[20];
#pragma unroll
        for (int h = 0; h < 20; ++h) { if (isl || h >= 16) { x1[h] = rp[h * 128 + e1]; x2[h] = rp[h * 128 + e2]; } else { x1[h] = 0.f; x2[h] = 0.f; } }
#pragma unroll
        for (int h = 0; h < 20; ++h) {
            if (isl || h >= 16) {
                const bool isq = h < 16;
                const float ss = wave_sum(x1[h] * x1[h] + x2[h] * x2[h]);
                const float r = rsqrtf(ss * (1.f / 128.f) + 1e-6f);
                const float y1 = x1[h] * r * (isq ? qg1 : kg1), y2 = x2[h] * r * (isq ? qg2 : kg2);
                const float o1 = y1 * cs - y2 * sn, o2 = y2 * cs + y1 * sn;
                bf16_t* dp = isq ? QB + (size_t)row * DM + h * 128 : KB + (size_t)kvrow * KVD + (h - 16) * 128;
                const unsigned pk = cvt_pk_bf16(o1, o2);
                dp[e1] = (bf16_t)(pk & 0xffffu); dp[e2] = (bf16_t)(pk >> 16);
            }
        }
    }
}

namespace att {
constexpr int D = 128, NW = 8, QBLK = 32, KVBLK = 64;
constexpr float SCALE = 0.088388347648318440f;
constexpr float THR = 8.f;
constexpr int LDQ = DM, LDK = KVD, LDO = DM;
constexpr size_t SHM_V = KVBLK * D * 2, SHM_K = KVBLK * D * 2;
#define KSWZ(row, colB) ((row) * 256 + ((colB) ^ (((row) & 7) << 4)))
#define SBAR() __builtin_amdgcn_sched_barrier(0)
__device__ __forceinline__ void partialSM(f32x16& p0, f32x16& p1, float& m_reg, float& mn, float& alpha) {
  constexpr float C = SCALE * 1.4426950408889634f;
  float pmax = p0[0];
#pragma unroll
  for (int r = 1; r < 16; ++r) pmax = fmaxf(pmax, p0[r]);
#pragma unroll
  for (int r = 0; r < 16; ++r) pmax = fmaxf(pmax, p1[r]);
  { auto rr = __builtin_amdgcn_permlane32_swap(__float_as_uint(pmax), __float_as_uint(pmax), false, false);
    pmax = fmaxf(__uint_as_float(rr[0]), __uint_as_float(rr[1])); }
  if (__builtin_expect(__all(pmax - m_reg <= THR / SCALE), 1)) { mn = m_reg; alpha = 1.f; }
  else { mn = fmaxf(m_reg, pmax); alpha = __builtin_amdgcn_exp2f((m_reg - mn) * C); m_reg = mn; }
  float mnC = -mn * C;
#pragma unroll
  for (int r = 0; r < 16; ++r) p0[r] = fmaf(p0[r], C, mnC);
#pragma unroll
  for (int r = 0; r < 16; ++r) p1[r] = fmaf(p1[r], C, mnC);
#pragma unroll
  for (int r = 0; r < 16; ++r) p0[r] = __builtin_amdgcn_exp2f(p0[r]);
}
__device__ __forceinline__ void finishSM(f32x16& p0, f32x16& p1, float alpha, float& l_reg, bf16x8& pa0, bf16x8& pa1, bf16x8& pa2, bf16x8& pa3) {
#pragma unroll
  for (int r = 0; r < 16; ++r) p1[r] = __builtin_amdgcn_exp2f(p1[r]);
  float ps = 0;
#pragma unroll
  for (int r = 0; r < 16; ++r) ps += p0[r];
#pragma unroll
  for (int r = 0; r < 16; ++r) ps += p1[r];
  { auto rr = __builtin_amdgcn_permlane32_swap(__float_as_uint(ps), __float_as_uint(ps), false, false);
    ps = __uint_as_float(rr[0]) + __uint_as_float(rr[1]); }
  l_reg = l_reg * alpha + ps;
#define PK4(P, BASE, OUT) do { unsigned a0 = cvt_pk_bf16(P[BASE + 0], P[BASE + 1]), a1 = cvt_pk_bf16(P[BASE + 2], P[BASE + 3]);   \
    unsigned b0 = cvt_pk_bf16(P[BASE + 4], P[BASE + 5]), b1 = cvt_pk_bf16(P[BASE + 6], P[BASE + 7]);                              \
    auto r0 = __builtin_amdgcn_permlane32_swap(a0, b0, false, false); auto r1 = __builtin_amdgcn_permlane32_swap(a1, b1, false, false); \
    u32x4 w = {r0[0], r1[0], r0[1], r1[1]}; OUT = *reinterpret_cast<bf16x8*>(&w); } while (0)
  PK4(p0, 0, pa0); PK4(p0, 8, pa1); PK4(p1, 0, pa2); PK4(p1, 8, pa3);
#undef PK4
}
__device__ __forceinline__ void qkt(f32x16& p0, f32x16& p1, const bf16_t* Ks, const bf16x8* qr, int r32, int hi) {
  p0 = f32x16{}; p1 = f32x16{};
#pragma unroll
  for (int d0 = 0; d0 < 8; ++d0) { int cb = (d0 * 16 + hi * 8) * 2;
    bf16x8 b0 = *reinterpret_cast<const bf16x8*>((const char*)Ks + KSWZ(r32, cb));
    bf16x8 b1 = *reinterpret_cast<const bf16x8*>((const char*)Ks + KSWZ(32 + r32, cb));
    p0 = __builtin_amdgcn_mfma_f32_32x32x16_bf16(b0, qr[d0], p0, 0, 0, 0);
    p1 = __builtin_amdgcn_mfma_f32_32x32x16_bf16(b1, qr[d0], p1, 0, 0, 0); }
}
__device__ __forceinline__ int v_st(int k, int c) { const int kk = (k & ~0xC) | ((k & 4) << 1) | ((k & 8) >> 1); return ((kk >> 3) * 4 + (c >> 5)) * 512 + ((kk & 7) * 32 + (c & 31)) * 2; }
__device__ __forceinline__ int v_rd_base(int lane) { return ((lane & 3) << 3) | (((lane >> 2) & 3) << 6) | (((lane >> 4) & 1) << 5) | (((lane >> 5) & 1) << 8); }
constexpr int v_rd_off(int d0, int ks, int half) { return d0 * 512 + ks * 4096 + half * 2048; }
template <int OFF> __device__ __forceinline__ s16x4 tr_read(int vb) {
  s16x4 r; asm volatile("ds_read_b64_tr_b16 %0, %1 offset:%2" : "=&v"(r) : "v"(vb), "i"(OFF) : "memory"); return r;
}
template <int D0> __device__ __forceinline__ void pv_one(f32x16& od, int vb, bf16x8 pa0, bf16x8 pa1, bf16x8 pa2, bf16x8 pa3) {
  const s16x4 l0 = tr_read<v_rd_off(D0, 0, 0)>(vb), h0 = tr_read<v_rd_off(D0, 0, 1)>(vb), l1 = tr_read<v_rd_off(D0, 1, 0)>(vb), h1 = tr_read<v_rd_off(D0, 1, 1)>(vb);
  const s16x4 l2 = tr_read<v_rd_off(D0, 2, 0)>(vb), h2 = tr_read<v_rd_off(D0, 2, 1)>(vb), l3 = tr_read<v_rd_off(D0, 3, 0)>(vb), h3 = tr_read<v_rd_off(D0, 3, 1)>(vb);
  asm volatile("s_waitcnt lgkmcnt(0)" ::: "memory"); SBAR();
#define PK(L, H) (bf16x8){L[0], L[1], L[2], L[3], H[0], H[1], H[2], H[3]}
  od = __builtin_amdgcn_mfma_f32_32x32x16_bf16(pa0, PK(l0, h0), od, 0, 0, 0);
  od = __builtin_amdgcn_mfma_f32_32x32x16_bf16(pa1, PK(l1, h1), od, 0, 0, 0);
  od = __builtin_amdgcn_mfma_f32_32x32x16_bf16(pa2, PK(l2, h2), od, 0, 0, 0);
  od = __builtin_amdgcn_mfma_f32_32x32x16_bf16(pa3, PK(l3, h3), od, 0, 0, 0);
#undef PK
}
__device__ __forceinline__ void pv_d0(f32x16* o, int vb, bf16x8 pa0, bf16x8 pa1, bf16x8 pa2, bf16x8 pa3) {
  pv_one<0>(o[0], vb, pa0, pa1, pa2, pa3); pv_one<1>(o[1], vb, pa0, pa1, pa2, pa3); pv_one<2>(o[2], vb, pa0, pa1, pa2, pa3); pv_one<3>(o[3], vb, pa0, pa1, pa2, pa3);
}
__device__ __forceinline__ void attn_dense_body(const bf16_t* __restrict__ Qb, const bf16_t* __restrict__ Kh, const bf16_t* __restrict__ Vh, bf16_t* __restrict__ Ob, int seq, char* lds) {
  const int tid = otid(), wid = tid >> 6, lane = tid & 63, r32 = lane & 31, hi = lane >> 5;
  bf16_t* V_lds = (bf16_t*)lds; bf16_t* K_lds = (bf16_t*)(lds + 2 * SHM_V);
  float* ws = (float*)(lds + 2 * SHM_V + 2 * SHM_K) + wid * 64; float* li_l = ws; float* al_l = ws + 32;
  float m_reg = -1e30f, l_reg = 0; f32x16 o[4] = {}; bf16x8 qr[8];
  const bf16_t* Qw = Qb + (long)(wid * QBLK + r32) * LDQ + hi * 8;
#pragma unroll
  for (int d0 = 0; d0 < 8; ++d0) qr[d0] = *reinterpret_cast<const bf16x8*>(Qw + d0 * 16);
  const int sr = tid >> 4, sc = (tid & 15) * 8, vst0 = v_st(sr, sc), vst1 = v_st(32 + sr, sc);
  const int vb0 = (int)(uintptr_t)V_lds + v_rd_base(lane);
  struct { bf16x8 vs0, vs1, ks0, ks1; } sr_[2];
#define SLOAD(i, k0) do { sr_[i].vs0 = *reinterpret_cast<const bf16x8*>(&Vh[(long)((k0) + sr) * LDK + sc]); sr_[i].vs1 = *reinterpret_cast<const bf16x8*>(&Vh[(long)((k0) + 32 + sr) * LDK + sc]); \
    sr_[i].ks0 = *reinterpret_cast<const bf16x8*>(&Kh[(long)((k0) + sr) * LDK + sc]); sr_[i].ks1 = *reinterpret_cast<const bf16x8*>(&Kh[(long)((k0) + 32 + sr) * LDK + sc]); } while (0)
#define SWRITE(b, i) do { *(bf16x8*)((char*)V_lds + (b) * SHM_V + vst0) = sr_[i].vs0;          \
    *(bf16x8*)((char*)V_lds + (b) * SHM_V + vst1) = sr_[i].vs1; int kc = sc * 2;               \
    *(bf16x8*)((char*)K_lds + (b) * SHM_K + KSWZ(sr, kc)) = sr_[i].ks0;                       \
    *(bf16x8*)((char*)K_lds + (b) * SHM_K + KSWZ(32 + sr, kc)) = sr_[i].ks1; } while (0)
#define SWAIT() asm volatile("s_waitcnt vmcnt(4)" ::: "memory")
#define RESC(a) do { if (__any((a) < 1.f)) { if (hi == 0) al_l[r32] = (a); asm volatile("s_waitcnt lgkmcnt(0)" ::: "memory"); \
    _Pragma("unroll") for (int d = 0; d < 4; ++d) _Pragma("unroll") for (int r = 0; r < 16; ++r) o[d][r] *= al_l[crow(r, hi)]; } } while (0)
  f32x16 pA0, pA1, pB0, pB1; float mnA, mnB, alA, alB; bf16x8 pa0, pa1, pa2, pa3; const int NT = seq / KVBLK;
  constexpr int SE = 0, SO = 1;
  SLOAD(SE, 0); asm volatile("s_waitcnt vmcnt(0)" ::: "memory"); SWRITE(0, SE); __syncthreads();
  qkt(pA0, pA1, K_lds, qr, r32, hi); partialSM(pA0, pA1, m_reg, mnA, alA);
  SLOAD(SO, KVBLK); if (2 < NT) SLOAD(SE, 2 * KVBLK);
  SWAIT(); SWRITE(1, SO); __syncthreads();
  for (int j = 1; j + 1 < NT; j += 2) {
    SBAR(); qkt(pB0, pB1, (bf16_t*)((char*)K_lds + SHM_K), qr, r32, hi);
    finishSM(pA0, pA1, alA, l_reg, pa0, pa1, pa2, pa3); SBAR();
    SLOAD(SO, (j + 2) * KVBLK); SBAR();
    pv_d0(o, vb0, pa0, pa1, pa2, pa3); partialSM(pB0, pB1, m_reg, mnB, alB);
    __syncthreads(); SWAIT(); SWRITE(0, SE);
    RESC(alB); __syncthreads();
    SBAR(); qkt(pA0, pA1, K_lds, qr, r32, hi);
    finishSM(pB0, pB1, alB, l_reg, pa0, pa1, pa2, pa3); SBAR();
    if (j + 3 < NT) SLOAD(SE, (j + 3) * KVBLK); SBAR();
    pv_d0(o, vb0 + (int)SHM_V, pa0, pa1, pa2, pa3); partialSM(pA0, pA1, m_reg, mnA, alA);
    __syncthreads(); SWAIT(); SWRITE(1, SO);
    RESC(alA); __syncthreads();
  }
  SBAR(); qkt(pB0, pB1, (bf16_t*)((char*)K_lds + SHM_K), qr, r32, hi);
  finishSM(pA0, pA1, alA, l_reg, pa0, pa1, pa2, pa3); SBAR();
  pv_d0(o, vb0, pa0, pa1, pa2, pa3); partialSM(pB0, pB1, m_reg, mnB, alB);
  __syncthreads(); RESC(alB);
  finishSM(pB0, pB1, alB, l_reg, pa0, pa1, pa2, pa3); SBAR();
  pv_d0(o, vb0 + (int)SHM_V, pa0, pa1, pa2, pa3);
  if (hi == 0) li_l[r32] = l_reg; asm volatile("s_waitcnt lgkmcnt(0)" ::: "memory");
  float rli[16];
#pragma unroll
  for (int r = 0; r < 16; ++r) rli[r] = __builtin_amdgcn_rcpf(li_l[crow(r, hi)]);
  bf16_t* Ow = Ob + (long)(wid * QBLK) * LDO;
#pragma unroll
  for (int r = 0; r < 16; ++r) { int orow = crow(r, hi);
#pragma unroll
    for (int d0 = 0; d0 < 4; ++d0) { const unsigned pk = cvt_pk_bf16(o[d0][r] * rli[r], 0.f); Ow[(long)orow * LDO + d0 * 32 + r32] = (bf16_t)(pk & 0xffffu); } }
  __syncthreads();
#undef SLOAD
#undef SWRITE
#undef SWAIT
#undef RESC
}
}

__device__ __forceinline__ void attn_phase(const Params& P, unsigned char* lds_raw) {
    const bf16_t* QB = (const bf16_t*)(P.ws + WS_QB); const bf16_t* KB = (const bf16_t*)(P.ws + WS_KB); const bf16_t* VB = (const bf16_t*)(P.ws + WS_VB); bf16_t* OB = (bf16_t*)(P.ws + WS_OB);
    const int G = gridDim.x, c = obid();
    for (int u = c, r = 0; u < 512; u += G, ++r) {
        int qblk = u & 7, hq = (u >> 3) & 15, b = u >> 7;
        if (G == 256) {
            const int set = 8 * r + (c & 7), q = c >> 3; b = set >> 2; hq = (set & 3) * 4 + (q >> 3); qblk = q & 7;
        }
        const int kvh = hq >> 2;
        const size_t q0 = ((size_t)b * SEQ + qblk * 256) * DM + hq * 128, k0 = (size_t)b * TKV * KVD + kvh * 128;
        att::attn_dense_body(QB + q0, KB + k0, VB + k0, OB + q0, TKV, (char*)lds_raw);
    }
}

__global__ void __launch_bounds__(512, 2) fwd_kernel(Params P) {
    extern __shared__ __attribute__((aligned(16))) unsigned char lds[];
    cg::grid_group grid = cg::this_grid();
    unsigned char* ws = P.ws;
    float* H = (float*)(ws + WS_H); bf16_t* Abuf = (bf16_t*)(ws + WS_A); bf16_t* HID = (bf16_t*)(ws + WS_HID);
    const float* mod = (const float*)(ws + WS_MOD);
    const int G = gridDim.x;
    volatile LAS unsigned* stw = (volatile LAS unsigned*)((LAS unsigned char*)lds + LDS_MAIN);
    if (threadIdx.x < 4) stw[threadIdx.x] = 0u;
    __syncthreads();
    XcdBarrier xbar = xcd_barrier_post((unsigned*)(ws + WS_BAR), stw);
#ifdef EXTRA_SYNCS
    for (int i = 0; i < EXTRA_SYNCS; ++i) grid.sync();
#endif
#if PROBE_GROUP >= 0
    unsigned long long t_prev = __builtin_amdgcn_s_memrealtime(), t_sum = 0; int prev_kind = -1;
#endif
    int ph_first = P.ph_lo;
#ifdef RPH
    int rph_left = 1;
#endif
#pragma unroll 1
    for (int ph = P.ph_lo; ph < P.ph_hi; ++ph) {
        if (ph > ph_first) { if (P.ph_lo < 0) grid.sync(); else xcd_barrier(xbar); }
        int kind = 0, l = ph >= 13 ? 1 : 0, wi = 0, nmt = 0;
        switch (ph) {
            case 0: kind = 0; break;
            case 1: kind = 1; nmt = 0; break;   case 2: kind = 2; wi = 0; break;   case 3: kind = 3; wi = 0; break;   case 4: kind = 4; wi = 0; break;
            case 5: kind = 1; nmt = 1; break;   case 6: kind = 5; break;           case 7: kind = 6; break;           case 8: kind = 7; break;
            case 9: kind = 1; nmt = 2; break;   case 10: kind = 2; wi = 1; break;  case 11: kind = 3; wi = 1; break;  case 12: kind = 4; wi = 1; break;
            case 13: kind = 1; nmt = 0; break;  case 14: kind = 2; wi = 2; break;  case 15: kind = 3; wi = 2; break;  case 16: kind = 4; wi = 2; break;
            case 17: kind = 1; nmt = 1; break;  case 18: kind = 8; break;          case 19: kind = 9; break;          case 20: kind = 10; break;  case 21: kind = 11; break;
            case 22: kind = 1; nmt = 2; break;  case 23: kind = 12; wi = 3; break; default: kind = 4; wi = 3; break;
        }
        const bool legacy = (G != 256);
#if PROBE_GROUP >= 0
        { const unsigned long long t_now = __builtin_amdgcn_s_memrealtime();
          const int grp = prev_kind == 0 ? 0 : (prev_kind == 2 || prev_kind == 3 || prev_kind == 4 || prev_kind == 7 || prev_kind == 8 || prev_kind == 11 || prev_kind == 12) ? 1 : prev_kind == 5 ? 2 : prev_kind == 10 ? 3 : prev_kind == 1 ? 4 : 5;
          if (prev_kind >= 0 && grp == PROBE_GROUP) t_sum += t_now - t_prev;
          t_prev = t_now; prev_kind = kind; }
#endif
        const float* modl = mod + (size_t)l * 5 * NMODC;
        if (kind == 0) { p0_phase(P, lds); }
        else if (kind == 1) {
            const float* sl = H; const float* sx = H + (size_t)MLAT * DM; int nrows = MTOT; const float* gn; int chs, chc;
            if (ph == 1) { sl = P.in[0]; sx = P.in[2]; }
            if (ph == 22) nrows = MLAT;
            if (nmt == 0) { gn = P.in[6] + l * DM; chs = 0; chc = 1; }
            else if (nmt == 1) { gn = P.in[7] + l * DM; chs = 3; chc = 4; }
            else { gn = P.in[8] + l * DM; chs = 6; chc = 7; }
            normmod_phase(sl, sx, nrows, gn, modl, chs, chc, Abuf);
        }
        else if (kind == 5) { s5_phase(P, lds); }
        else if (kind == 6) { s5_merge_phase(P); }
        else if (kind == 9) { qknorm_phase(P); }
        else if (kind == 10) { attn_phase(P, lds); }
        else {
            const int cp = (obid() & 7) * 32 + (obid() >> 3);
            const int ncalls = (kind == 3 && !legacy && cp >= 224) ? 2 : 1;
#pragma unroll 1
            for (int call = 0; call < ncalls; ++call) {
                pg8::Gemm g; pg8::EpiAny E; pg8::StaticOrder S;
                E.sw = pg8::EpiSwiglu{HID, DFF};
                E.rs.res_lat = H; E.rs.res_ctx = H + (size_t)MLAT * DM; E.rs.out_lat = H; E.rs.out_ctx = H + (size_t)MLAT * DM; E.rs.coef = 0.5f;
                E.rs.gate = modl + (size_t)((wi & 1) ? 8 : 2) * DM;
                if (wi == 0) { E.rs.res_lat = P.in[0]; E.rs.res_ctx = P.in[2]; }
                if (wi == 3) { E.rs.out_lat = P.out; E.rs.out_ctx = P.out; }
                E.gl = pg8::EpiGlu{H, modl + (size_t)5 * DM};
                E.f3 = pg8::EpiF32{(float*)(ws + WS_QKV), NQKV, (bf16_t*)(ws + WS_VB)};
                const bf16_t* Wgu = (const bf16_t*)(ws + WS_WGU + (size_t)wi * SZ_WGU); const bf16_t* Wd = (const bf16_t*)(ws + WS_WD + (size_t)wi * SZ_WD);
                if (kind == 2 || kind == 12 || (kind == 3 && call == 0)) {
                    const int M = (kind == 12) ? MLAT : MTOT;
                    g = pg8::Gemm{Abuf, Wgu, M, 2 * DFF, DM}; E.mode = 0; S.init(M, 2 * DFF, G, obid());
                    if (kind == 2 && !legacy) S.mode = 1;
                    if (kind == 3) S.mode = legacy ? 4 : 2;
                } else if (kind == 3) {
                    g = pg8::Gemm{HID, Wd, MTOT, DM, DFF}; E.mode = 1; S.init(MTOT, DM, G, obid()); S.mode = 3; S.spm = 32 + ((cp - 224) & 3); S.spn = (cp - 224) >> 2;
                } else if (kind == 4) {
                    const int M = (legacy && wi != 3) ? MTOT : MLAT;
                    g = pg8::Gemm{HID, Wd, M, DM, DFF}; E.mode = 1; S.init(M, DM, G, obid());
                } else if (kind == 7) {
                    g = pg8::Gemm{(const bf16_t*)(ws + WS_Z), (const bf16_t*)(ws + WS_W12), MTOT, 4096, DM}; E.mode = 2; S.init(MTOT, 4096, G, obid());
                } else if (kind == 8) {
                    g = pg8::Gemm{Abuf, (const bf16_t*)(ws + WS_WQKV), MTOT, NQKV, DM}; E.mode = 3; S.init(MTOT, NQKV, G, obid());
                } else {
                    g = pg8::Gemm{(const bf16_t*)(ws + WS_OB), (const bf16_t*)(ws + WS_WO), MLAT, DM, DM}; E.mode = 1; E.rs.coef = 1.f; E.rs.gate = modl + (size_t)5 * DM; S.init(MLAT, DM, G, obid());
                    E.rs.res_lat = H; E.rs.out_lat = H;
                }
                pg8::gemm_phase((LAS unsigned char*)lds, g, S, E, E.mode == 0);
            }
            if (!legacy) {
                if (kind == 3 && cp >= 112 && cp < 224) { const int r = cp - 112;
                    if (wi == 0) convert_range(P, 0, r * TAIL_UB, r * TAIL_UB + TAIL_UB);
                    else { const int base = wi == 1 ? 3264 : 4160, lo = base + r * TAIL_UB, hi = lo + TAIL_UB; convert_range(P, 1, lo < 4864 ? lo : 4864, hi < 4864 ? hi : 4864); } }
                if (kind == 7 && obid() >= 64) { const int r = obid() - 64; convert_range(P, 1, 2112 + r * TAIL_GLU, 2112 + r * TAIL_GLU + TAIL_GLU); }
            }
        }
#ifdef RPH
        if (ph == RPH && rph_left > 0) { --rph_left; --ph; ph_first = -1; }
#endif
    }
#if PROBE_GROUP >= 0
    grid.sync();
    { const unsigned long long t_now = __builtin_amdgcn_s_memrealtime();
      const int grp = 1;
      if (grp == PROBE_GROUP) t_sum += t_now - t_prev;
      if (blockIdx.x == 0) {
          float* sh = (float*)lds;
          if (threadIdx.x == 0) sh[0] = 1e-3f * sqrtf((float)t_sum * 0.01f);
          __syncthreads();
          const float dl = sh[0];
          for (int i = threadIdx.x; i < 4096; i += 512) P.out[i] += dl;
      } }
#endif
}

extern "C" void kernel_launch(void* const* d_in, const int* in_sizes, int n_in, void* d_out, int out_size, void* d_ws, size_t ws_size, hipStream_t stream) {
    static int grid = 0;
    if (grid == 0) {
        if (n_in != 29 || ws_size < WS_END) { fprintf(stderr, "kernel_launch: unexpected n_in %d or ws_size %zu (< %zu)\n", n_in, ws_size, (size_t)WS_END); grid = -1; return; }
        int dev = 0, cus = 0, per_cu = 0;
        hipGetDevice(&dev);
        hipDeviceGetAttribute(&cus, hipDeviceAttributeMultiprocessorCount, dev);
        if (hipFuncSetAttribute((const void*)fwd_kernel, hipFuncAttributeMaxDynamicSharedMemorySize, LDS_BYTES) != hipSuccess) { fprintf(stderr, "kernel_launch: hipFuncSetAttribute failed\n"); grid = -1; return; }
        if (hipOccupancyMaxActiveBlocksPerMultiprocessor(&per_cu, (const void*)fwd_kernel, 512, LDS_BYTES) != hipSuccess || per_cu < 1) { fprintf(stderr, "kernel_launch: occupancy query says %d\n", per_cu); per_cu = 1; }
        (void)hipGetLastError();
        grid = cus * 1;
    }
    if (grid < 0) return;
    if (hipMemsetAsync((char*)d_ws + WS_BAR, 0, 16384, stream) != hipSuccess) { fprintf(stderr, "kernel_launch: memset failed\n"); return; }
    Params p{};
    for (int i = 0; i < 29; ++i) p.in[i] = (const float*)d_in[i];
    p.out = (float*)d_out; p.ws = (unsigned char*)d_ws;
#if MULTI_LAUNCH
    for (int ph = 0; ph < NPHASE; ++ph) {
        p.ph_lo = ph; p.ph_hi = ph + 1;
        hipLaunchKernelGGL(fwd_kernel, dim3(grid), dim3(512), LDS_BYTES, stream, p);
    }
#else
    p.ph_lo = 0; p.ph_hi = NPHASE;
    void* args[] = {&p};
    hipError_t e = hipLaunchCooperativeKernel((const void*)fwd_kernel, dim3(grid), dim3(512), args, LDS_BYTES, stream);
    if (e != hipSuccess) fprintf(stderr, "cooperative launch failed: %s (grid %d)\n", hipGetErrorString(e), grid);
#endif
}
```

```cpp
#include <hip/hip_runtime.h>
#include <hip/hip_cooperative_groups.h>
#include <cstdio>
#include <cstdint>
namespace cg = cooperative_groups;

#ifndef PROBE_GROUP
#define PROBE_GROUP -1
#endif
#ifndef MULTI_LAUNCH
#define MULTI_LAUNCH 0
#endif

typedef unsigned short bf16_t;
typedef short bf16x8 __attribute__((ext_vector_type(8)));
typedef short s16x4 __attribute__((ext_vector_type(4)));
typedef float f32x2 __attribute__((ext_vector_type(2)));
typedef float f32x4 __attribute__((ext_vector_type(4)));
typedef float f32x16 __attribute__((ext_vector_type(16)));
typedef unsigned u32x2 __attribute__((ext_vector_type(2)));
typedef unsigned u32x4 __attribute__((ext_vector_type(4)));
#define LAS __attribute__((address_space(3)))

constexpr int DM = 2048, NBATCH = 4, SEQ = 2048, CTXL = 256, DFF = 5632, NMODC = 9 * DM  ;
constexpr int MLAT = NBATCH * SEQ  , MCTX = NBATCH * CTXL  , MTOT = MLAT + MCTX  ;
constexpr int TKV = CTXL + SEQ  ;
constexpr int NQKV = 3072, KVD = 512;
constexpr int NPHASE = 25;
constexpr int LDS_MAIN = 131072, LDS_BYTES = LDS_MAIN + 64;

constexpr size_t SZ_WGU = (size_t)2 * DFF * DM * 2, SZ_WD = (size_t)DM * DFF * 2;
constexpr size_t WS_WGU = 0;
constexpr size_t WS_WD = WS_WGU + 4 * SZ_WGU;
constexpr size_t WS_W12 = WS_WD + 4 * SZ_WD;
constexpr size_t WS_WQKV = WS_W12 + (size_t)4096 * DM * 2;
constexpr size_t WS_WO = WS_WQKV + (size_t)NQKV * DM * 2;
constexpr size_t WS_MOD = WS_WO + (size_t)DM * DM * 2;
constexpr size_t WS_H = WS_MOD + (size_t)2 * 5 * NMODC * 4;
constexpr size_t WS_A = WS_H + (size_t)MTOT * DM * 4;
constexpr size_t WS_HID = WS_A + (size_t)MTOT * DM * 2;
constexpr size_t WS_YF = WS_HID + (size_t)MTOT * DFF * 2;
constexpr size_t WS_YB = WS_YF + (size_t)MTOT * DM * 4;
constexpr size_t WS_Z = WS_YB + (size_t)MTOT * DM * 4;
constexpr size_t WS_QKV = WS_Z + (size_t)MTOT * DM * 2;
constexpr size_t WS_QB = WS_QKV + (size_t)MTOT * NQKV * 4;
constexpr size_t WS_KB = WS_QB + (size_t)MLAT * DM * 2;
constexpr size_t WS_VB = WS_KB + (size_t)NBATCH * TKV * KVD * 2;
constexpr size_t WS_OB = WS_VB + (size_t)NBATCH * TKV * KVD * 2;
constexpr size_t WS_BAR = WS_OB + (size_t)MLAT * DM * 2;
constexpr size_t WS_END = WS_BAR + 16384;

struct Params {
    const float* in[29];
    float* out;
    unsigned char* ws;
    int ph_lo, ph_hi;
};

__device__ __forceinline__ unsigned cvt_pk_bf16(float lo, float hi) { unsigned r; asm volatile("v_cvt_pk_bf16_f32 %0, %1, %2" : "=v"(r) : "v"(lo), "v"(hi)); return r; }
__device__ __forceinline__ float fast_rcp(float x) { return __builtin_amdgcn_rcpf(x); }
__device__ __forceinline__ float sigmoidf_(float x) { return fast_rcp(1.f + __expf(-x)); }
__device__ __forceinline__ float siluf_(float x) { return x * sigmoidf_(x); }
__device__ __forceinline__ float gelu_tanh(float x) { const float y = 0.7978845608028654f * (x + 0.044715f * x * x * x); return x * sigmoidf_(2.f * y); }
__device__ __forceinline__ float wave_sum(float v) {
#pragma unroll
    for (int o = 32; o > 0; o >>= 1) v += __shfl_xor(v, o, 64);
    return v;
}
__device__ __forceinline__ int otid() { int t = threadIdx.x; asm volatile("" : "+v"(t)); return t; }
__device__ __forceinline__ int obid() { int b = blockIdx.x; asm volatile("" : "+s"(b)); return b; }
#define WAVE_LDS_SYNC() asm volatile("s_waitcnt lgkmcnt(0)" ::: "memory")


#define XB_TMO      128
#define XB_XCNT(j)  (256  + 64 * (j))
#define XB_XSUB(j)  (1280 + 64 * (j))
#define XB_XGEN(j)  (2304 + 64 * (j))
#define XB_TOP      3328
#define XB_TOPGEN   3392
#define XCD_BAR_WORDS 3456
#define XB_SPIN_CAP (1u << 22)
__device__ __forceinline__ unsigned xb_ld(unsigned* p)              { return __hip_atomic_load(p, __ATOMIC_RELAXED, __HIP_MEMORY_SCOPE_AGENT); }
__device__ __forceinline__ unsigned xb_add(unsigned* p, unsigned v) { return __hip_atomic_fetch_add(p, v, __ATOMIC_RELAXED, __HIP_MEMORY_SCOPE_AGENT); }
__device__ __forceinline__ unsigned xb_xcc_id() { return (unsigned)__builtin_amdgcn_s_getreg((3 << 11) | 20) & 0xFu; }
#define XB_SPIN(cond, bar) do { unsigned _sp = 0; while (cond) { __builtin_amdgcn_s_sleep(1); \
    if ((++_sp & 255u) == 0u) { if (xb_ld(&(bar)[XB_TMO])) break; if (_sp > XB_SPIN_CAP) { atomicAdd(&(bar)[XB_TMO], 1u); break; } } } } while (0)
struct XcdBarrier { unsigned* bar; unsigned x; volatile LAS unsigned* st; };
__device__ __forceinline__ XcdBarrier xcd_barrier_post(unsigned* bar, volatile LAS unsigned* st) {
    XcdBarrier b; b.bar = bar; b.x = xb_xcc_id(); b.st = st;
    if (threadIdx.x == 0) (void)xb_add(&bar[XB_XCNT(b.x)], 1u);
    return b;
}
__device__ __forceinline__ void xcd_barrier_complete(unsigned* bar, unsigned x, unsigned& nloc, unsigned& nx) {
    const unsigned G = gridDim.x * gridDim.y * gridDim.z;
    unsigned sum, cnt, mine, sp = 0u;
    for (;;) {
        sum = 0u; cnt = 0u; mine = 0u;
#pragma unroll
        for (unsigned j = 0; j < 16; ++j) { const unsigned c = xb_ld(&bar[XB_XCNT(j)]); sum += c; cnt += (c > 0u) ? 1u : 0u; mine = (j == x) ? c : mine; }
        if (sum == G) break;
        __builtin_amdgcn_s_sleep(1);
        if ((++sp & 255u) == 0u) { if (xb_ld(&bar[XB_TMO])) break; if (sp > XB_SPIN_CAP) { atomicAdd(&bar[XB_TMO], 1u); break; } }
    }
    nloc = mine > 0u ? mine : 1u; nx = cnt > 0u ? cnt : 1u;
}
__device__ __forceinline__ void xcd_barrier(const XcdBarrier& b) {
    asm volatile("s_waitcnt vmcnt(0)" ::: "memory");
    __syncthreads();
    if (threadIdx.x == 0) {
        unsigned* bar = b.bar;
        __builtin_amdgcn_s_waitcnt(0);
        unsigned nloc = b.st[0], nx = b.st[1];
        if (nloc == 0u) { xcd_barrier_complete(bar, b.x, nloc, nx); b.st[0] = nloc; b.st[1] = nx; }
        const unsigned old = xb_add(&bar[XB_XSUB(b.x)], 1u);
        const unsigned gen = old / nloc;
        if (old + 1u == (gen + 1u) * nloc) {
            __builtin_amdgcn_fence(__ATOMIC_RELEASE, "agent");
            asm volatile("s_waitcnt vmcnt(0)" ::: "memory");
            const unsigned og = xb_add(&bar[XB_TOP], 1u);
            const unsigned tg = og / nx;
            if (og + 1u == (tg + 1u) * nx) xb_add(&bar[XB_TOPGEN], 1u);
            else XB_SPIN(xb_ld(&bar[XB_TOPGEN]) == tg, bar);
            __builtin_amdgcn_fence(__ATOMIC_ACQUIRE, "agent");
            xb_add(&bar[XB_XGEN(b.x)], 1u);
            asm volatile("s_waitcnt vmcnt(0)" ::: "memory");
        } else {
            XB_SPIN(xb_ld(&bar[XB_XGEN(b.x)]) == gen, bar);
            __builtin_amdgcn_fence(__ATOMIC_ACQUIRE, "agent");
            asm volatile("s_waitcnt vmcnt(0)" ::: "memory");
        }
    }
    __syncthreads();
}

namespace pg8 {
constexpr int BM = 256, BK = 64, HALF = 128, HTB = HALF * BK * 2, STAGE_BYTES = 8 * HTB, NXCD = 8, WGM = 8;
__host__ __device__ __forceinline__ int lds_byte(int r, int c) { const int st = (r >> 4) * 2 + (c >> 5), rr = r & 15, cc = c & 31, ob = rr * 64 + cc * 2; return st * 1024 + (ob ^ (((ob >> 9) & 1) << 5)); }
__host__ __device__ __forceinline__ void stage_rc(int b, int& R, int& C) { const int st = b / 1024, sb = b % 1024, swz = sb ^ (((sb >> 9) & 1) << 5); R = (st >> 1) * 16 + swz / 64; C = (st & 1) * 32 + (swz % 64) / 2; }
__host__ __device__ __forceinline__ int perm32(int rho) { const int n = rho >> 4, i = rho & 15; return 8 * (i >> 2) + 4 * n + (i & 3); }
struct Unit { int pm, pn; };
struct Gemm { const bf16_t* A; const bf16_t* Bt; int M, N, K; };
struct StaticOrder {
    int nM, nN, nwg, G, c;
    int mode, cp, spm, spn;
    __device__ void init(int M, int N, int G_, int c_) { nM = M / BM; nN = N / BM; nwg = nM * nN; G = G_; c = c_; mode = 0; cp = (c_ & 7) * 32 + (c_ >> 3); spm = 0; spn = 0; }
    __device__ bool next(int i, Unit& u) const {
        if (mode == 0) {
            const long L = (long)i * G + c; if (L >= nwg) return false;
            int wgid = (int)L; { const int q = nwg / NXCD, r = nwg % NXCD, xcd = wgid % NXCD, off = wgid / NXCD; wgid = (xcd < r ? xcd * (q + 1) : r * (q + 1) + (xcd - r) * q) + off; }
            const int nig = WGM * nN, gid = wgid / nig, fm = gid * WGM, gsz = (nM - fm) < WGM ? (nM - fm) : WGM;
            u.pm = fm + ((wgid % nig) % gsz); u.pn = (wgid % nig) / gsz; return true;
        }
        if (mode == 4) return false;
        if (mode == 3) { if (i) return false; u.pm = spm; u.pn = spn; return true; }
        int ell;
        if (mode == 1) { if (i) return false; if (cp < 176) { u.pm = 32 + (cp & 3); u.pn = cp >> 2; return true; } ell = 1328 + cp - 176; }
        else { if (i < 3) ell = cp + 256 * i; else { if (cp >= 224) return false; ell = 768 + cp + 224 * (i - 3); if (ell >= 1328) return false; } }
        const int bl = ell >> 5, q = ell & 31; u.pm = (bl & 3) * 8 + (q & 7); u.pn = (bl >> 2) * 4 + (q >> 3); return true;
    }
};

struct EpiAny;
__device__ __forceinline__ void epi_any(const EpiAny& E, const f32x4 (&acc)[2][2][4][2], const Unit& u, int wr, int wc, int fr, int fq);
__device__ __forceinline__ void gemm_phase(LAS unsigned char* lds, const Gemm g, const StaticOrder& S, const EpiAny& E, const bool PERMB) {
    const int tid = otid(), wid = __builtin_amdgcn_readfirstlane(tid >> 6), lane = tid & 63, wr = wid >> 2, wc = wid & 3, fr = lane & 15, fq = lane >> 4;
    const int K = g.K, nt = K / BK;
    unsigned voffA[2], voffB[2];
#pragma unroll
    for (int i = 0; i < 2; ++i) { int R, C; stage_rc(tid * 16 + i * 8192, R, C); const int Rb = PERMB ? ((R & ~31) + perm32(R & 31)) : R;
        voffA[i] = (unsigned)(R * K + C) * 2u; voffB[i] = (unsigned)(Rb * K + C) * 2u; }
    const size_t kstep = (size_t)(BK * 2);
    const size_t hstep = (size_t)HALF * K * 2;
    const size_t tstep = 2 * hstep;
    const unsigned ldsw = (unsigned)wid * 1024u;
    const int aoff = lds_byte(wr * 64 + fr, fq * 8), boff = lds_byte(wc * 32 + fr, fq * 8);
#define PG8_SA(b, h) (((b) * 2 + (h)) * HTB)
#define PG8_SB(b, h) ((4 + (b) * 2 + (h)) * HTB)
#define PG8_STAGE(bufoff, gbase, voff) do { _Pragma("unroll") for (int _i = 0; _i < 2; ++_i) \
        __builtin_amdgcn_global_load_lds((const unsigned*)((const char*)(gbase) + (voff)[_i]), (LAS unsigned*)(lds + (bufoff) + ldsw + _i * 8192), 16, 0, 0); } while (0)
#define PG8_LDA(dst, b, h) do { _Pragma("unroll") for (int m = 0; m < 4; ++m) _Pragma("unroll") for (int k = 0; k < 2; ++k) dst[m][k] = *(const LAS bf16x8*)(lds + PG8_SA(b, h) + aoff + m * 2048 + k * 1024); } while (0)
#define PG8_LDB(dst, b, h) do { _Pragma("unroll") for (int n = 0; n < 2; ++n) _Pragma("unroll") for (int k = 0; k < 2; ++k) dst[n][k] = *(const LAS bf16x8*)(lds + PG8_SB(b, h) + boff + n * 2048 + k * 1024); } while (0)
#define PG8_MMA(ai, bj, At, Bt) do { __builtin_amdgcn_s_setprio(1); _Pragma("unroll") for (int m = 0; m < 4; ++m) _Pragma("unroll") for (int n = 0; n < 2; ++n) _Pragma("unroll") for (int k = 0; k < 2; ++k) \
        acc[ai][bj][m][n] = __builtin_amdgcn_mfma_f32_16x16x32_bf16(Bt[n][k], At[m][k], acc[ai][bj][m][n], 0, 0, 0); __builtin_amdgcn_s_setprio(0); } while (0)
#define PG8_WAIT_V(n) asm volatile("s_waitcnt vmcnt(" #n ")" ::: "memory")
#define PG8_WAIT_L(n) asm volatile("s_waitcnt lgkmcnt(" #n ")" ::: "memory")
#define PG8_BAR __builtin_amdgcn_s_barrier()
#define PG8_SCHED __builtin_amdgcn_sched_barrier(0)
    Unit cur, nxt; int ui = 0;
    if (!S.next(0, cur)) return;
    f32x4 acc[2][2][4][2];
#pragma unroll
    for (int a = 0; a < 2; ++a)
#pragma unroll
        for (int b = 0; b < 2; ++b)
#pragma unroll
            for (int m = 0; m < 4; ++m)
#pragma unroll
                for (int n = 0; n < 2; ++n) acc[a][b][m][n] = (f32x4){0.f, 0.f, 0.f, 0.f};
    bf16x8 At[4][2], B0[2][2], B1[2][2];
    const char* cA = (const char*)g.A + (size_t)cur.pm * tstep; const char* cB = (const char*)g.Bt + (size_t)cur.pn * tstep;
    PG8_STAGE(PG8_SB(0, 0), cB, voffB); PG8_STAGE(PG8_SA(0, 0), cA, voffA); PG8_STAGE(PG8_SB(0, 1), cB + hstep, voffB); PG8_STAGE(PG8_SA(0, 1), cA + hstep, voffA);
    if (wr == 1) PG8_BAR;
    PG8_WAIT_V(4); PG8_BAR;
    PG8_STAGE(PG8_SB(1, 0), cB + kstep, voffB); PG8_STAGE(PG8_SA(1, 0), cA + kstep, voffA); PG8_STAGE(PG8_SB(1, 1), cB + hstep + kstep, voffB);
    PG8_WAIT_V(6); PG8_BAR;
    for (;;) {
        const bool has_next = S.next(ui + 1, nxt);
        const char* nA = has_next ? (const char*)g.A + (size_t)nxt.pm * tstep : cA; const char* nB = has_next ? (const char*)g.Bt + (size_t)nxt.pn * tstep : cB;
        for (int t = 0; t < nt; t += 2) {
            const bool last = (t == nt - 2);
            const char* a1 = cA + (size_t)(t + 1) * kstep;
            const char* a2 = last ? nA : cA + (size_t)(t + 2) * kstep; const char* b2 = last ? nB : cB + (size_t)(t + 2) * kstep;
            const char* a3 = a2 + kstep; const char* b3 = b2 + kstep;
            PG8_LDB(B0, 0, 0); PG8_SCHED; PG8_LDA(At, 0, 0); PG8_STAGE(PG8_SA(1, 1), a1 + hstep, voffA);
            PG8_WAIT_L(8); PG8_BAR; PG8_WAIT_L(0); PG8_MMA(0, 0, At, B0); PG8_BAR; PG8_SCHED;
            PG8_LDB(B1, 0, 1); PG8_STAGE(PG8_SB(0, 0), b2, voffB);
            PG8_BAR; PG8_WAIT_L(0); PG8_MMA(0, 1, At, B1); PG8_BAR;
            PG8_LDA(At, 0, 1); PG8_STAGE(PG8_SA(0, 0), a2, voffA);
            PG8_BAR; PG8_WAIT_L(0); PG8_MMA(1, 0, At, B0); PG8_BAR; PG8_SCHED;
            PG8_STAGE(PG8_SB(0, 1), b2 + hstep, voffB);
            PG8_WAIT_V(6); PG8_BAR; PG8_MMA(1, 1, At, B1); PG8_BAR;
            PG8_LDB(B0, 1, 0); PG8_SCHED; PG8_LDA(At, 1, 0); PG8_STAGE(PG8_SA(0, 1), a2 + hstep, voffA);
            PG8_WAIT_L(8); PG8_BAR; PG8_WAIT_L(0); PG8_MMA(0, 0, At, B0); PG8_BAR; PG8_SCHED;
            PG8_LDB(B1, 1, 1); PG8_STAGE(PG8_SB(1, 0), b3, voffB);
            PG8_BAR; PG8_WAIT_L(0); PG8_MMA(0, 1, At, B1); PG8_BAR;
            PG8_LDA(At, 1, 1); PG8_STAGE(PG8_SA(1, 0), a3, voffA);
            PG8_BAR; PG8_WAIT_L(0); PG8_MMA(1, 0, At, B0); PG8_BAR; PG8_SCHED;
            PG8_STAGE(PG8_SB(1, 1), b3 + hstep, voffB);
            PG8_WAIT_V(6); PG8_BAR; PG8_MMA(1, 1, At, B1); PG8_BAR;
        }
        epi_any(E, acc, cur, wr, wc, fr, fq);
        if (!has_next) break;
#pragma unroll
        for (int a = 0; a < 2; ++a)
#pragma unroll
            for (int b = 0; b < 2; ++b)
#pragma unroll
                for (int m = 0; m < 4; ++m)
#pragma unroll
                    for (int n = 0; n < 2; ++n) acc[a][b][m][n] = (f32x4){0.f, 0.f, 0.f, 0.f};
        cur = nxt; cA = nA; cB = nB; ++ui;
    }
    PG8_WAIT_V(0);
    if (wr == 0) PG8_BAR;
    PG8_BAR;
#undef PG8_SA
#undef PG8_SB
#undef PG8_STAGE
#undef PG8_LDA
#undef PG8_LDB
#undef PG8_MMA
#undef PG8_WAIT_V
#undef PG8_WAIT_L
#undef PG8_BAR
#undef PG8_SCHED
}

struct EpiSwiglu {
    static constexpr bool PERM = true;
    bf16_t* O; int ldo;
    __device__ __forceinline__ void operator()(const f32x4 (&acc)[2][2][4][2], const Unit& u, int wr, int wc, int fr, int fq) const {
        const int row0 = u.pm * BM + wr * 64 + fr, col0 = u.pn * HALF + wc * 32 + 8 * fq;
#pragma unroll
        for (int ai = 0; ai < 2; ++ai)
#pragma unroll
            for (int m = 0; m < 4; ++m) {
                bf16_t* rowp = O + (size_t)(row0 + ai * HALF + m * 16) * ldo + col0;
                float v[8];
#pragma unroll
                for (int n = 0; n < 2; ++n)
#pragma unroll
                    for (int j = 0; j < 4; ++j) { const float gt = acc[ai][0][m][n][j], up = acc[ai][1][m][n][j]; v[n * 4 + j] = siluf_(gt) * up; }
                u32x4 w; w.x = cvt_pk_bf16(v[0], v[1]); w.y = cvt_pk_bf16(v[2], v[3]); w.z = cvt_pk_bf16(v[4], v[5]); w.w = cvt_pk_bf16(v[6], v[7]);
                *(u32x4*)rowp = w;
            }
    }
};
struct EpiResid {
    static constexpr bool PERM = false;
    const float* res_lat; const float* res_ctx; float* out_lat; float* out_ctx; const float* gate; float coef;
    __device__ __forceinline__ void operator()(const f32x4 (&acc)[2][2][4][2], const Unit& u, int wr, int wc, int fr, int fq) const {
        const int row0 = u.pm * BM + wr * 64 + fr, col0 = u.pn * BM + wc * 32 + 4 * fq;
        const bool isl = u.pm < MLAT / BM; const int mrow = isl ? (u.pm >> 3) : 4;
        const float* rb = isl ? res_lat : res_ctx - (size_t)MLAT * DM; float* ob = isl ? out_lat : out_ctx - (size_t)MLAT * DM;
        const float* gp = gate + (size_t)mrow * NMODC;
#pragma unroll
        for (int bj = 0; bj < 2; ++bj) {
            f32x4 gv[2];
#pragma unroll
            for (int n = 0; n < 2; ++n) gv[n] = *(const f32x4*)(gp + col0 + bj * HALF + n * 16);
#pragma unroll
            for (int ai = 0; ai < 2; ++ai) {
                f32x4 r[4][2];
#pragma unroll
                for (int m = 0; m < 4; ++m) { const size_t ro = (size_t)(row0 + ai * HALF + m * 16) * DM + col0 + bj * HALF;
#pragma unroll
                    for (int n = 0; n < 2; ++n) r[m][n] = *(const f32x4*)(rb + ro + n * 16); }
#pragma unroll
                for (int m = 0; m < 4; ++m) { const size_t ro = (size_t)(row0 + ai * HALF + m * 16) * DM + col0 + bj * HALF;
#pragma unroll
                    for (int n = 0; n < 2; ++n) *(f32x4*)(ob + ro + n * 16) = r[m][n] + (gv[n] * coef) * acc[ai][bj][m][n]; }
            }
        }
    }
};
struct EpiGlu {
    static constexpr bool PERM = false;
    float* h; const float* gate;
    __device__ __forceinline__ void operator()(const f32x4 (&acc)[2][2][4][2], const Unit& u, int wr, int wc, int fr, int fq) const {
        const int row0 = u.pm * BM + wr * 64 + fr, col0 = u.pn * HALF + wc * 32 + 4 * fq;
        const int mrow = u.pm < MLAT / BM ? (u.pm >> 3) : 4;
        const float* gp = gate + (size_t)mrow * NMODC;
        f32x4 gv[2];
#pragma unroll
        for (int n = 0; n < 2; ++n) gv[n] = *(const f32x4*)(gp + col0 + n * 16);
#pragma unroll
        for (int ai = 0; ai < 2; ++ai) {
            f32x4 r[4][2];
#pragma unroll
            for (int m = 0; m < 4; ++m) { const float* rowp = h + (size_t)(row0 + ai * HALF + m * 16) * DM + col0;
#pragma unroll
                for (int n = 0; n < 2; ++n) r[m][n] = *(const f32x4*)(rowp + n * 16); }
#pragma unroll
            for (int m = 0; m < 4; ++m) { float* rowp = h + (size_t)(row0 + ai * HALF + m * 16) * DM + col0;
#pragma unroll
                for (int n = 0; n < 2; ++n) { f32x4 o = r[m][n]; const f32x4 a1 = acc[ai][0][m][n], a2 = acc[ai][1][m][n];
#pragma unroll
                    for (int j = 0; j < 4; ++j) o[j] += gv[n][j] * a1[j] * sigmoidf_(a2[j]);
                    *(f32x4*)(rowp + n * 16) = o; } }
        }
    }
};
struct EpiF32 {
    static constexpr bool PERM = false;
    float* C; int ldc; bf16_t* VB;
    __device__ __forceinline__ void operator()(const f32x4 (&acc)[2][2][4][2], const Unit& u, int wr, int wc, int fr, int fq) const {
        const int row0 = u.pm * BM + wr * 64 + fr, col0 = u.pn * BM + wc * 32 + 4 * fq;
        if (u.pm >= MLAT / BM && u.pn < 8) return;
        if (u.pn >= 10) {
            const int kv0 = u.pm < MLAT / BM ? (u.pm >> 3) * TKV + CTXL + ((u.pm & 7) * BM) : (u.pm - MLAT / BM) * TKV;
            const int vc0 = (u.pn - 10) * BM + wc * 32 + 4 * fq;
#pragma unroll
            for (int ai = 0; ai < 2; ++ai)
#pragma unroll
                for (int m = 0; m < 4; ++m) { bf16_t* rowp = VB + (size_t)(kv0 + wr * 64 + fr + ai * HALF + m * 16) * KVD + vc0;
#pragma unroll
                    for (int bj = 0; bj < 2; ++bj)
#pragma unroll
                        for (int n = 0; n < 2; ++n) { const f32x4 a = acc[ai][bj][m][n]; u32x2 pk; pk.x = cvt_pk_bf16(a[0], a[1]); pk.y = cvt_pk_bf16(a[2], a[3]); *(u32x2*)(rowp + bj * HALF + n * 16) = pk; } }
            return;
        }
#pragma unroll
        for (int ai = 0; ai < 2; ++ai)
#pragma unroll
            for (int m = 0; m < 4; ++m) { float* rowp = C + (size_t)(row0 + ai * HALF + m * 16) * ldc + col0;
#pragma unroll
                for (int bj = 0; bj < 2; ++bj)
#pragma unroll
                    for (int n = 0; n < 2; ++n) *(f32x4*)(rowp + bj * HALF + n * 16) = acc[ai][bj][m][n]; }
    }
};
struct EpiAny { int mode; EpiSwiglu sw; EpiResid rs; EpiGlu gl; EpiF32 f3; };
__device__ __forceinline__ void epi_any(const EpiAny& E, const f32x4 (&acc)[2][2][4][2], const Unit& u, int wr, int wc, int fr, int fq) {
    if (E.mode == 0) E.sw(acc, u, wr, wc, fr, fq);
    else if (E.mode == 1) E.rs(acc, u, wr, wc, fr, fq);
    else if (E.mode == 2) E.gl(acc, u, wr, wc, fr, fq);
    else E.f3(acc, u, wr, wc, fr, fq);
}
}

__device__ __forceinline__ void transpose_item(const Params& P, int t, int lane, int wbase, int wstep) {
    const float* src; bf16_t* dst; int K, N, nb, kb, pair;
    if (t < 8448) {
        const int q = t / 704, r = t % 704, lf = q / 3, kind = q % 3, l = lf >> 1, f = lf & 1;
        if (kind < 2) { K = DM; N = DFF; nb = r >> 3; kb = r & 7; src = P.in[9 + f * 3 + kind] + (size_t)l * DM * DFF; dst = (bf16_t*)(P.ws + WS_WGU + (size_t)lf * SZ_WGU); pair = 1 + kind; }
        else { K = DFF; N = DM; nb = r / 22; kb = r % 22; src = P.in[11 + f * 3] + (size_t)l * DM * DFF; dst = (bf16_t*)(P.ws + WS_WD + (size_t)lf * SZ_WD); pair = 0; }
    } else {
        const int r = t - 8448;
        if (r < 512) { K = DM; N = DM; nb = (r & 255) >> 3; kb = r & 7; src = P.in[r < 256 ? 23 : 24]; dst = (bf16_t*)(P.ws + WS_W12); pair = r < 256 ? 1 : 2; }
        else if (r < 896) { const int r2 = r - 512; K = DM; N = NQKV; nb = r2 >> 3; kb = r2 & 7; src = P.in[25]; dst = (bf16_t*)(P.ws + WS_WQKV); pair = 0; }
        else { const int r2 = r - 896; K = DM; N = DM; nb = r2 >> 3; kb = r2 & 7; src = P.in[26]; dst = (bf16_t*)(P.ws + WS_WO); pair = 0; }
    }
    const int n = nb * 64 + lane;
    const int nr = pair == 0 ? n : ((n >> 7) * 256 + (pair - 1) * 128 + (n & 127));
    if (wstep == 8) {
        const int k0 = kb * 256 + wbase * 32;
        const float* sp = src + (size_t)k0 * N + n;
        float v[32];
#pragma unroll
        for (int j = 0; j < 32; ++j) v[j] = __builtin_nontemporal_load(sp + (size_t)j * N);
        bf16_t* dp = dst + (size_t)nr * K + k0;
#pragma unroll
        for (int cblk = 0; cblk < 4; ++cblk) { u32x4 o; o.x = cvt_pk_bf16(v[cblk * 8 + 0], v[cblk * 8 + 1]); o.y = cvt_pk_bf16(v[cblk * 8 + 2], v[cblk * 8 + 3]); o.z = cvt_pk_bf16(v[cblk * 8 + 4], v[cblk * 8 + 5]); o.w = cvt_pk_bf16(v[cblk * 8 + 6], v[cblk * 8 + 7]);
            *(u32x4*)(dp + cblk * 8) = o; }
    } else {
        const int k0 = kb * 256 + wbase * 64;
        const float* sp = src + (size_t)k0 * N + n;
        float v[64];
#pragma unroll
        for (int j = 0; j < 64; ++j) v[j] = __builtin_nontemporal_load(sp + (size_t)j * N);
        bf16_t* dp = dst + (size_t)nr * K + k0;
#pragma unroll
        for (int cblk = 0; cblk < 8; ++cblk) { u32x4 o; o.x = cvt_pk_bf16(v[cblk * 8 + 0], v[cblk * 8 + 1]); o.y = cvt_pk_bf16(v[cblk * 8 + 2], v[cblk * 8 + 3]); o.z = cvt_pk_bf16(v[cblk * 8 + 4], v[cblk * 8 + 5]); o.w = cvt_pk_bf16(v[cblk * 8 + 6], v[cblk * 8 + 7]);
            *(u32x4*)(dp + cblk * 8) = o; }
    }
}

template <int NK> __device__ __forceinline__ void trn_load(const Params& P, int t, int lane, int wq, float (&v)[NK], bf16_t*& dp) {
    const float* src; bf16_t* dst; int K, N, nb, kb, pair;
    if (t < 8448) {
        const int q = t / 704, r = t % 704, lf = q / 3, kind = q % 3, l = lf >> 1, f = lf & 1;
        if (kind < 2) { K = DM; N = DFF; nb = r >> 3; kb = r & 7; src = P.in[9 + f * 3 + kind] + (size_t)l * DM * DFF; dst = (bf16_t*)(P.ws + WS_WGU + (size_t)lf * SZ_WGU); pair = 1 + kind; }
        else { K = DFF; N = DM; nb = r / 22; kb = r % 22; src = P.in[11 + f * 3] + (size_t)l * DM * DFF; dst = (bf16_t*)(P.ws + WS_WD + (size_t)lf * SZ_WD); pair = 0; }
    } else {
        const int r = t - 8448;
        if (r < 512) { K = DM; N = DM; nb = (r & 255) >> 3; kb = r & 7; src = P.in[r < 256 ? 23 : 24]; dst = (bf16_t*)(P.ws + WS_W12); pair = r < 256 ? 1 : 2; }
        else if (r < 896) { const int r2 = r - 512; K = DM; N = NQKV; nb = r2 >> 3; kb = r2 & 7; src = P.in[25]; dst = (bf16_t*)(P.ws + WS_WQKV); pair = 0; }
        else { const int r2 = r - 896; K = DM; N = DM; nb = r2 >> 3; kb = r2 & 7; src = P.in[26]; dst = (bf16_t*)(P.ws + WS_WO); pair = 0; }
    }
    const int n = nb * 64 + lane;
    const int nr = pair == 0 ? n : ((n >> 7) * 256 + (pair - 1) * 128 + (n & 127));
    const int k0 = kb * 256 + wq * NK;
    const float* sp = src + (size_t)k0 * N + n;
#pragma unroll
    for (int j = 0; j < NK; ++j) v[j] = __builtin_nontemporal_load(sp + (size_t)j * N);
    dp = dst + (size_t)nr * K + k0;
}
template <int NK> __device__ __forceinline__ void trn_store(const float (&v)[NK], bf16_t* dp) {
#pragma unroll
    for (int cblk = 0; cblk < NK / 8; ++cblk) { u32x4 o; o.x = cvt_pk_bf16(v[cblk * 8 + 0], v[cblk * 8 + 1]); o.y = cvt_pk_bf16(v[cblk * 8 + 2], v[cblk * 8 + 3]); o.z = cvt_pk_bf16(v[cblk * 8 + 4], v[cblk * 8 + 5]); o.w = cvt_pk_bf16(v[cblk * 8 + 6], v[cblk * 8 + 7]);
        *(u32x4*)(dp + cblk * 8) = o; }
}
constexpr int NDEFER = 288, NIMMED = 3616, TAIL_UB = 10, TAIL_GLU = 8, TAIL_QKV = 10;
__device__ __forceinline__ int late_item(int q);
__device__ __forceinline__ int deferred_item(int d) { return late_item(4576 + d); }
__device__ __forceinline__ int imm_item(int i, int G) { return (G != 256 || i < 2112) ? i : i < 2624 ? 8448 + (i - 2112) : 3232 + (i - 2624); }
__device__ __forceinline__ int late_item(int q) { return q < 2112 ? 4224 + q : q < 2752 ? 8960 + (q - 2112) : 6336 + (q - 2752); }
__device__ __forceinline__ void convert_range(const Params& P, int list, int lo, int hi) {
    const int tid = otid(), lane = tid & 63, w = tid >> 6;
    float va[32], vb[32]; bf16_t* dpa = nullptr; bf16_t* dpb = nullptr;
    int i = lo;
    if (i < hi) trn_load<32>(P, list ? late_item(i) : 2112 + i, lane, w, va, dpa);
#pragma unroll 1
    for (; i < hi; i += 2) {
        const int i1 = i + 1, i2 = i + 2;
        if (i1 < hi) trn_load<32>(P, list ? late_item(i1) : 2112 + i1, lane, w, vb, dpb);
        trn_store<32>(va, dpa);
        if (i2 < hi) trn_load<32>(P, list ? late_item(i2) : 2112 + i2, lane, w, va, dpa);
        if (i1 < hi) trn_store<32>(vb, dpb);
    }
}

__device__ __forceinline__ void p0_phase(const Params& P, unsigned char* lds_raw) {
    const int tid = otid(), lane = tid & 63, w = tid >> 6;
    float* s_lds = (float*)lds_raw;
    float* red = s_lds + 5 * DM;
    const float* c = P.in[1]; const float* cc = P.in[3];
    for (int i = tid; i < 5 * DM; i += 512) { const int r = i >> 11, k = i & (DM - 1); const float v = r < 4 ? c[r * DM + k] : cc[k]; s_lds[i] = siluf_(v); }
    __syncthreads();
    const float* ada_w = P.in[4]; const float* ada_b = P.in[5];
    float* mod = (float*)(P.ws + WS_MOD);
    const int G = gridDim.x, bx = obid();
    for (int item = bx; item < 576; item += G) {
        const int l = item / 288, n0 = (item % 288) * 64;
        const float* wp = ada_w + ((size_t)l * DM + w * 256) * NMODC + n0 + lane;
        float a0 = 0.f, a1 = 0.f, a2 = 0.f, a3 = 0.f, a4 = 0.f;
        const float* sp = s_lds + w * 256;
#pragma unroll 1
        for (int k0 = 0; k0 < 256; k0 += 16) {
            float wv[16];
#pragma unroll
            for (int j = 0; j < 16; ++j) wv[j] = __builtin_nontemporal_load(wp + (size_t)(k0 + j) * NMODC);
#pragma unroll
            for (int j = 0; j < 16; ++j) { const int k = k0 + j; a0 += sp[k] * wv[j]; a1 += sp[DM + k] * wv[j]; a2 += sp[2 * DM + k] * wv[j]; a3 += sp[3 * DM + k] * wv[j]; a4 += sp[4 * DM + k] * wv[j]; }
        }
        red[(w * 5 + 0) * 64 + lane] = a0; red[(w * 5 + 1) * 64 + lane] = a1; red[(w * 5 + 2) * 64 + lane] = a2; red[(w * 5 + 3) * 64 + lane] = a3; red[(w * 5 + 4) * 64 + lane] = a4;
        __syncthreads();
        if (tid < 320) { const int r = tid >> 6; float s = ada_b[(size_t)l * NMODC + n0 + lane];
#pragma unroll
            for (int ww = 0; ww < 8; ++ww) s += red[(ww * 5 + r) * 64 + lane];
            mod[((size_t)l * 5 + r) * NMODC + n0 + lane] = s; }
        __syncthreads();
    }
    int t_lo, t_hi;
    if (G == 256) { if (bx < 64) { t_lo = 10 * bx; t_hi = t_lo + 10; } else { t_lo = 640 + (int)(((long)(bx - 64) * 2976) / 192); t_hi = 640 + (int)(((long)(bx - 63) * 2976) / 192); } }
    else { t_lo = (int)(((long)bx * 9600) / G); t_hi = (int)(((long)(bx + 1) * 9600) / G); }
    {
        float va[32], vb[32]; bf16_t* dpa = nullptr; bf16_t* dpb = nullptr;
        int i = t_lo;
        if (i < t_hi) trn_load<32>(P, imm_item(i, G), lane, w, va, dpa);
#pragma unroll 1
        for (; i < t_hi; i += 2) {
            const int i1 = i + 1, i2 = i + 2;
            if (i1 < t_hi) trn_load<32>(P, imm_item(i1, G), lane, w, vb, dpb);
            trn_store<32>(va, dpa);
            if (i2 < t_hi) trn_load<32>(P, imm_item(i2, G), lane, w, va, dpa);
            if (i1 < t_hi) trn_store<32>(vb, dpb);
        }
    }
}

__device__ __forceinline__ void normmod_phase(const float* src_lat, const float* src_ctx, int nrows, const float* gnorm, const float* modl, int ch_shift, int ch_scale, bf16_t* dst) {
    const int lane = otid() & 63, gw = obid() * 8 + (otid() >> 6);
    const int pr = gw >> 1, odd = gw & 1, nw = gridDim.x * 8;
    const int per2 = (2 * nrows + nw - 1) / nw, h1 = (per2 + 1) >> 1;
    int r0 = pr * per2 + (odd ? h1 : 0), r1 = r0 + (odd ? per2 - h1 : h1);
    if (r1 > nrows) r1 = nrows;
    if (r0 >= r1) return;
    f32x4 v[8], vn[8], wq[8], shq[8];
    { const float* sp = r0 < MLAT ? src_lat + (size_t)r0 * DM : src_ctx + (size_t)(r0 - MLAT) * DM;
#pragma unroll
      for (int i = 0; i < 8; ++i) v[i] = *(const f32x4*)(sp + (i * 64 + lane) * 4); }
    int cur_mrow = -1;
#pragma unroll 1
    for (int row = r0; row < r1; ++row) {
        const int nrow = row + 1;
        if (nrow < r1) { const float* sp = nrow < MLAT ? src_lat + (size_t)nrow * DM : src_ctx + (size_t)(nrow - MLAT) * DM;
#pragma unroll
            for (int i = 0; i < 8; ++i) vn[i] = *(const f32x4*)(sp + (i * 64 + lane) * 4); }
        const int mrow = row < MLAT ? (row >> 11) : 4;
        if (mrow != cur_mrow) {
            cur_mrow = mrow;
            const float* shp = modl + (size_t)mrow * NMODC + ch_shift * DM; const float* scp = modl + (size_t)mrow * NMODC + ch_scale * DM;
#pragma unroll
            for (int i = 0; i < 8; ++i) { const int d = (i * 64 + lane) * 4; const f32x4 g4 = *(const f32x4*)(gnorm + d), sc = *(const f32x4*)(scp + d); shq[i] = *(const f32x4*)(shp + d); wq[i] = g4 * (sc + 1.f); }
        }
        float ss = 0.f;
#pragma unroll
        for (int i = 0; i < 8; ++i) ss += v[i][0] * v[i][0] + v[i][1] * v[i][1] + v[i][2] * v[i][2] + v[i][3] * v[i][3];
        ss = wave_sum(ss);
        const float r = rsqrtf(ss * (1.f / DM) + 1e-6f);
        bf16_t* dp = dst + (size_t)row * DM;
#pragma unroll
        for (int i = 0; i < 8; ++i) { const int d = (i * 64 + lane) * 4;
            const f32x4 o = v[i] * r * wq[i] + shq[i];
            u32x2 pk; pk.x = cvt_pk_bf16(o[0], o[1]); pk.y = cvt_pk_bf16(o[2], o[3]); *(u32x2*)(dp + d) = pk; }
#pragma unroll
        for (int i = 0; i < 8; ++i) v[i] = vn[i];
    }
}

__device__ __forceinline__ int crow(int r, int hi) { return (r & 3) + 8 * (r >> 2) + 4 * hi; }
constexpr int S5_BU_STRIDE = 36  , S5_BU_BYTES = 128 * S5_BU_STRIDE * 4, S5_HS_STRIDE = 272, S5_HS_BYTES = 32 * S5_HS_STRIDE, S5_WAVE_BYTES = S5_BU_BYTES + S5_HS_BYTES;
__device__ __forceinline__ void s5_phase(const Params& P, unsigned char* lds_raw) {
    const int tid = otid(), lane = tid & 63, w = tid >> 6;
    if (w >= 4) {
        const int G = gridDim.x, wq = w - 4;
        if (G != 256) return;
        float va[64], vb[64]; bf16_t* dpa = nullptr; bf16_t* dpb = nullptr;
        int d = obid();
        if (d < NDEFER) trn_load<64>(P, deferred_item(d), lane, wq, va, dpa);
#pragma unroll 1
        for (; d < NDEFER; d += 2 * G) {
            const int d2 = d + G, d3 = d + 2 * G;
            if (d2 < NDEFER) trn_load<64>(P, deferred_item(d2), lane, wq, vb, dpb);
            trn_store<64>(va, dpa);
            if (d3 < NDEFER) trn_load<64>(P, deferred_item(d3), lane, wq, va, dpa);
            if (d2 < NDEFER) trn_store<64>(vb, dpb);
        }
        return;
    }
    float* bu = (float*)(lds_raw + w * S5_WAVE_BYTES);
    unsigned char* hs = lds_raw + w * S5_WAVE_BYTES + S5_BU_BYTES;
    const bf16_t* U = (const bf16_t*)(P.ws + WS_A);
    const float* a_re = P.in[15]; const float* a_im = P.in[16]; const float* log_dt = P.in[17];
    const float* b_re = P.in[18]; const float* b_im = P.in[19]; const float* c_re = P.in[20]; const float* c_im = P.in[21];
    const int l31 = lane & 31, hi = lane >> 5, l15 = lane & 15, q4 = lane >> 4;
    for (int item = obid() * 4 + w; item < 1024; item += gridDim.x * 4) {
        const int dir = item & 1, g = (item >> 1) & 127, b = item >> 8;
        const int base = dir * 128 + g;
        const float dt = expf(log_dt[base]);
        float lre, lim;
        { const float are = a_re[base * 64 + lane], aim = a_im[base * 64 + lane]; const float mag = expf(are * dt); float s, c; sincosf(aim * dt, &s, &c); lre = mag * c; lim = mag * s; }
        bf16x8 Bf[4];
#pragma unroll
        for (int nb = 0; nb < 4; ++nb) {
            const int q = (nb & 1) * 32 + l31, comp = nb >> 1;
            const float are = a_re[base * 64 + q], aim = a_im[base * 64 + q]; const float mag = expf(are * dt); float s, c; sincosf(aim * dt, &s, &c);
            const float nre = mag * c - 1.f, nim = mag * s, den = fast_rcp(are * are + aim * aim);
            const float cre = (nre * are + nim * aim) * den, cim = (nim * are - nre * aim) * den;
            const float* br = b_re + ((size_t)base * 64 + q) * 16 + 8 * hi; const float* bi = b_im + ((size_t)base * 64 + q) * 16 + 8 * hi;
            float o[8];
#pragma unroll
            for (int j = 0; j < 8; ++j) { const float xr = br[j], xi = bi[j]; o[j] = comp == 0 ? (cre * xr - cim * xi) : (cre * xi + cim * xr); }
            u32x4 pk; pk.x = cvt_pk_bf16(o[0], o[1]); pk.y = cvt_pk_bf16(o[2], o[3]); pk.z = cvt_pk_bf16(o[4], o[5]); pk.w = cvt_pk_bf16(o[6], o[7]);
            Bf[nb] = *(bf16x8*)&pk;
        }
        bf16x8 Cf[4];
#pragma unroll
        for (int kb = 0; kb < 4; ++kb) {
            float o[8];
#pragma unroll
            for (int j = 0; j < 8; ++j) { const int k = kb * 32 + 8 * q4 + j, p = k >> 1; const size_t ci = ((size_t)base * 16 + l15) * 64 + p; o[j] = (k & 1) ? -c_im[ci] : c_re[ci]; }
            u32x4 pk; pk.x = cvt_pk_bf16(o[0], o[1]); pk.y = cvt_pk_bf16(o[2], o[3]); pk.z = cvt_pk_bf16(o[4], o[5]); pk.w = cvt_pk_bf16(o[6], o[7]);
            Cf[kb] = *(bf16x8*)&pk;
        }
        float* Y = (float*)(P.ws + (dir ? WS_YB : WS_YF));
        float hre = 0.f, him = 0.f;
        auto rowof = [&](int blk, int t) -> int {
            const int tau = blk * 32 + t;
            if (tau < CTXL) return MLAT + b * CTXL + (dir ? (CTXL - 1 - tau) : tau);
            const int s = tau - CTXL; return b * SEQ + (dir ? (SEQ - 1 - s) : s);
        };
        const int sgn = dir ? -1 : 1; const long sd = (long)sgn * DM;
        bf16x8 afr = *(const bf16x8*)(U + (size_t)(rowof(0, 0) + sgn * l31) * DM + g * 16 + 8 * hi);
#pragma unroll 1
        for (int blk = 0; blk < 72; ++blk) {
            const bf16x8 acur = afr;
            const int rbase = rowof(blk, 0);
            if (blk + 1 < 72) afr = *(const bf16x8*)(U + (size_t)(rowof(blk + 1, 0) + sgn * l31) * DM + g * 16 + 8 * hi);
#pragma unroll
            for (int nb = 0; nb < 4; ++nb) {
                f32x16 acc = {};
                acc = __builtin_amdgcn_mfma_f32_32x32x16_bf16(acur, Bf[nb], acc, 0, 0, 0);
                float* colp = bu + (nb * 32 + l31) * S5_BU_STRIDE + 4 * hi;
#pragma unroll
                for (int k = 0; k < 4; ++k) *(f32x4*)(colp + 8 * k) = (f32x4){acc[4 * k], acc[4 * k + 1], acc[4 * k + 2], acc[4 * k + 3]};
            }
            WAVE_LDS_SYNC();
#pragma unroll
            for (int th = 0; th < 2; ++th) {
                f32x4 bre4[4], bim4[4];
#pragma unroll
                for (int q = 0; q < 4; ++q) { bre4[q] = *(const f32x4*)(bu + lane * S5_BU_STRIDE + th * 16 + 4 * q); bim4[q] = *(const f32x4*)(bu + (64 + lane) * S5_BU_STRIDE + th * 16 + 4 * q); }
#pragma unroll
                for (int t = 0; t < 16; ++t) {
                    const float nre = fmaf(lre, hre, fmaf(-lim, him, bre4[t >> 2][t & 3])), nim = fmaf(lre, him, fmaf(lim, hre, bim4[t >> 2][t & 3]));
                    hre = nre; him = nim;
                    *(unsigned*)(hs + (th * 16 + t) * S5_HS_STRIDE + lane * 4) = cvt_pk_bf16(hre, him);
                }
            }
            WAVE_LDS_SYNC();
            float* yp = Y + (size_t)(rbase + sgn * (q4 * 4)) * DM + g * 16 + l15;
#pragma unroll
            for (int tb = 0; tb < 2; ++tb) {
                f32x4 acc = {0.f, 0.f, 0.f, 0.f};
#pragma unroll
                for (int kb = 0; kb < 4; ++kb) { const bf16x8 a = *(const bf16x8*)(hs + (tb * 16 + l15) * S5_HS_STRIDE + kb * 64 + q4 * 16); acc = __builtin_amdgcn_mfma_f32_16x16x32_bf16(a, Cf[kb], acc, 0, 0, 0); }
#pragma unroll
                for (int j = 0; j < 4; ++j) yp[(long)(tb * 16 + j) * sd] = acc[j];
            }
            WAVE_LDS_SYNC();
        }
    }
}

__device__ __forceinline__ void s5_merge_phase(const Params& P) {
    const float* __restrict__ yf = (const float*)(P.ws + WS_YF); const float* __restrict__ yb = (const float*)(P.ws + WS_YB); const bf16_t* __restrict__ U = (const bf16_t*)(P.ws + WS_A); bf16_t* __restrict__ Z = (bf16_t*)(P.ws + WS_Z);
    const float* dsk = P.in[22];
    const size_t n4 = (size_t)MTOT * DM / 4, stride = (size_t)gridDim.x * 512;
    for (size_t i0 = (size_t)obid() * 512 + otid(); i0 < n4; i0 += 4 * stride) {
        f32x4 a[4], bq[4]; u32x2 uu[4];
#pragma unroll
        for (int k = 0; k < 4; ++k) { const size_t i = i0 + k * stride; if (i < n4) { a[k] = __builtin_nontemporal_load((const f32x4*)(yf + i * 4)); bq[k] = __builtin_nontemporal_load((const f32x4*)(yb + i * 4)); uu[k] = *(const u32x2*)(U + i * 4); } }
#pragma unroll
        for (int k = 0; k < 4; ++k) { const size_t i = i0 + k * stride; if (i < n4) {
            const f32x4 d4 = *(const f32x4*)(dsk + ((i * 4) & (DM - 1)));
            const float u0 = __uint_as_float(uu[k].x << 16), u1 = __uint_as_float(uu[k].x & 0xffff0000u), u2 = __uint_as_float(uu[k].y << 16), u3 = __uint_as_float(uu[k].y & 0xffff0000u);
            const float z0 = gelu_tanh(a[k][0] + bq[k][0] + d4[0] * u0), z1 = gelu_tanh(a[k][1] + bq[k][1] + d4[1] * u1), z2 = gelu_tanh(a[k][2] + bq[k][2] + d4[2] * u2), z3 = gelu_tanh(a[k][3] + bq[k][3] + d4[3] * u3);
            u32x2 o; o.x = cvt_pk_bf16(z0, z1); o.y = cvt_pk_bf16(z2, z3); *(u32x2*)(Z + i * 4) = o; } }
    }
}

__device__ __forceinline__ void qknorm_phase(const Params& P) {
    const float* QKV = (const float*)(P.ws + WS_QKV); bf16_t* QB = (bf16_t*)(P.ws + WS_QB); bf16_t* KB = (bf16_t*)(P.ws + WS_KB); bf16_t* VB = (bf16_t*)(P.ws + WS_VB);
    const float* qg = P.in[27]; const float* kg = P.in[28];
    const int lane = otid() & 63, gw = obid() * 8 + (otid() >> 6), nw = gridDim.x * 8;
    const int i31 = lane & 31, e1 = lane < 32 ? lane : 32 + lane, e2 = e1 + 32;
    const float freq = exp2f(-(float)i31 * (13.287712379549449f / 32.f));
    const float qg1 = qg[e1], qg2 = qg[e2], kg1 = kg[e1], kg2 = kg[e2];
    for (int row = gw; row < MTOT; row += nw) {
        const bool isl = row < MLAT;
        float cs = 1.f, sn = 0.f; int kvrow;
        if (isl) { const int b = row >> 11, s = row & (SEQ - 1); const int pos = lane < 32 ? (s >> 6) : (s & 63); sincosf((float)pos * freq, &sn, &cs); kvrow = b * TKV + CTXL + s; }
        else { const int r = row - MLAT, b = r >> 8, lidx = r & (CTXL - 1); kvrow = b * TKV + lidx; }
        const float* rp = QKV + (size_t)row * NQKV;
        float x1[20], x2[20];
#pragma unroll
        for (int h = 0; h < 20; ++h) { if (isl || h >= 16) { x1[h] = rp[h * 128 + e1]; x2[h] = rp[h * 128 + e2]; } else { x1[h] = 0.f; x2[h] = 0.f; } }
#pragma unroll
        for (int h = 0; h < 20; ++h) {
            if (isl || h >= 16) {
                const bool isq = h < 16;
                const float ss = wave_sum(x1[h] * x1[h] + x2[h] * x2[h]);
                const float r = rsqrtf(ss * (1.f / 128.f) + 1e-6f);
                const float y1 = x1[h] * r * (isq ? qg1 : kg1), y2 = x2[h] * r * (isq ? qg2 : kg2);
                const float o1 = y1 * cs - y2 * sn, o2 = y2 * cs + y1 * sn;
                bf16_t* dp = isq ? QB + (size_t)row * DM + h * 128 : KB + (size_t)kvrow * KVD + (h - 16) * 128;
                const unsigned pk = cvt_pk_bf16(o1, o2);
                dp[e1] = (bf16_t)(pk & 0xffffu); dp[e2] = (bf16_t)(pk >> 16);
            }
        }
    }
}

namespace att {
constexpr int D = 128, NW = 8, QBLK = 32, KVBLK = 64;
constexpr float SCALE = 0.088388347648318440f;
constexpr float THR = 8.f;
constexpr int LDQ = DM, LDK = KVD, LDO = DM;
constexpr size_t SHM_V = KVBLK * D * 2, SHM_K = KVBLK * D * 2;
#define KSWZ(row, colB) ((row) * 256 + ((colB) ^ (((row) & 7) << 4)))
#define SBAR() __builtin_amdgcn_sched_barrier(0)
__device__ __forceinline__ void partialSM(f32x16& p0, f32x16& p1, float& m_reg, float& mn, float& alpha) {
  constexpr float C = SCALE * 1.4426950408889634f;
  float pmax = p0[0];
#pragma unroll
  for (int r = 1; r < 16; ++r) pmax = fmaxf(pmax, p0[r]);
#pragma unroll
  for (int r = 0; r < 16; ++r) pmax = fmaxf(pmax, p1[r]);
  { auto rr = __builtin_amdgcn_permlane32_swap(__float_as_uint(pmax), __float_as_uint(pmax), false, false);
    pmax = fmaxf(__uint_as_float(rr[0]), __uint_as_float(rr[1])); }
  if (__builtin_expect(__all(pmax - m_reg <= THR / SCALE), 1)) { mn = m_reg; alpha = 1.f; }
  else { mn = fmaxf(m_reg, pmax); alpha = __builtin_amdgcn_exp2f((m_reg - mn) * C); m_reg = mn; }
  float mnC = -mn * C;
#pragma unroll
  for (int r = 0; r < 16; ++r) p0[r] = fmaf(p0[r], C, mnC);
#pragma unroll
  for (int r = 0; r < 16; ++r) p1[r] = fmaf(p1[r], C, mnC);
#pragma unroll
  for (int r = 0; r < 16; ++r) p0[r] = __builtin_amdgcn_exp2f(p0[r]);
}
__device__ __forceinline__ void finishSM(f32x16& p0, f32x16& p1, float alpha, float& l_reg, bf16x8& pa0, bf16x8& pa1, bf16x8& pa2, bf16x8& pa3) {
#pragma unroll
  for (int r = 0; r < 16; ++r) p1[r] = __builtin_amdgcn_exp2f(p1[r]);
  float ps = 0;
#pragma unroll
  for (int r = 0; r < 16; ++r) ps += p0[r];
#pragma unroll
  for (int r = 0; r < 16; ++r) ps += p1[r];
  { auto rr = __builtin_amdgcn_permlane32_swap(__float_as_uint(ps), __float_as_uint(ps), false, false);
    ps = __uint_as_float(rr[0]) + __uint_as_float(rr[1]); }
  l_reg = l_reg * alpha + ps;
#define PK4(P, BASE, OUT) do { unsigned a0 = cvt_pk_bf16(P[BASE + 0], P[BASE + 1]), a1 = cvt_pk_bf16(P[BASE + 2], P[BASE + 3]);   \
    unsigned b0 = cvt_pk_bf16(P[BASE + 4], P[BASE + 5]), b1 = cvt_pk_bf16(P[BASE + 6], P[BASE + 7]);                              \
    auto r0 = __builtin_amdgcn_permlane32_swap(a0, b0, false, false); auto r1 = __builtin_amdgcn_permlane32_swap(a1, b1, false, false); \
    u32x4 w = {r0[0], r1[0], r0[1], r1[1]}; OUT = *reinterpret_cast<bf16x8*>(&w); } while (0)
  PK4(p0, 0, pa0); PK4(p0, 8, pa1); PK4(p1, 0, pa2); PK4(p1, 8, pa3);
#undef PK4
}
__device__ __forceinline__ void qkt(f32x16& p0, f32x16& p1, const bf16_t* Ks, const bf16x8* qr, int r32, int hi) {
  p0 = f32x16{}; p1 = f32x16{};
#pragma unroll
  for (int d0 = 0; d0 < 8; ++d0) { int cb = (d0 * 16 + hi * 8) * 2;
    bf16x8 b0 = *reinterpret_cast<const bf16x8*>((const char*)Ks + KSWZ(r32, cb));
    bf16x8 b1 = *reinterpret_cast<const bf16x8*>((const char*)Ks + KSWZ(32 + r32, cb));
    p0 = __builtin_amdgcn_mfma_f32_32x32x16_bf16(b0, qr[d0], p0, 0, 0, 0);
    p1 = __builtin_amdgcn_mfma_f32_32x32x16_bf16(b1, qr[d0], p1, 0, 0, 0); }
}
__device__ __forceinline__ int v_st(int k, int c) { const int kk = (k & ~0xC) | ((k & 4) << 1) | ((k & 8) >> 1); return ((kk >> 3) * 4 + (c >> 5)) * 512 + ((kk & 7) * 32 + (c & 31)) * 2; }
__device__ __forceinline__ int v_rd_base(int lane) { return ((lane & 3) << 3) | (((lane >> 2) & 3) << 6) | (((lane >> 4) & 1) << 5) | (((lane >> 5) & 1) << 8); }
constexpr int v_rd_off(int d0, int ks, int half) { return d0 * 512 + ks * 4096 + half * 2048; }
template <int OFF> __device__ __forceinline__ s16x4 tr_read(int vb) {
  s16x4 r; asm volatile("ds_read_b64_tr_b16 %0, %1 offset:%2" : "=&v"(r) : "v"(vb), "i"(OFF) : "memory"); return r;
}
template <int D0> __device__ __forceinline__ void pv_one(f32x16& od, int vb, bf16x8 pa0, bf16x8 pa1, bf16x8 pa2, bf16x8 pa3) {
  const s16x4 l0 = tr_read<v_rd_off(D0, 0, 0)>(vb), h0 = tr_read<v_rd_off(D0, 0, 1)>(vb), l1 = tr_read<v_rd_off(D0, 1, 0)>(vb), h1 = tr_read<v_rd_off(D0, 1, 1)>(vb);
  const s16x4 l2 = tr_read<v_rd_off(D0, 2, 0)>(vb), h2 = tr_read<v_rd_off(D0, 2, 1)>(vb), l3 = tr_read<v_rd_off(D0, 3, 0)>(vb), h3 = tr_read<v_rd_off(D0, 3, 1)>(vb);
  asm volatile("s_waitcnt lgkmcnt(0)" ::: "memory"); SBAR();
#define PK(L, H) (bf16x8){L[0], L[1], L[2], L[3], H[0], H[1], H[2], H[3]}
  od = __builtin_amdgcn_mfma_f32_32x32x16_bf16(pa0, PK(l0, h0), od, 0, 0, 0);
  od = __builtin_amdgcn_mfma_f32_32x32x16_bf16(pa1, PK(l1, h1), od, 0, 0, 0);
  od = __builtin_amdgcn_mfma_f32_32x32x16_bf16(pa2, PK(l2, h2), od, 0, 0, 0);
  od = __builtin_amdgcn_mfma_f32_32x32x16_bf16(pa3, PK(l3, h3), od, 0, 0, 0);
#undef PK
}
__device__ __forceinline__ void pv_d0(f32x16* o, int vb, bf16x8 pa0, bf16x8 pa1, bf16x8 pa2, bf16x8 pa3) {
  pv_one<0>(o[0], vb, pa0, pa1, pa2, pa3); pv_one<1>(o[1], vb, pa0, pa1, pa2, pa3); pv_one<2>(o[2], vb, pa0, pa1, pa2, pa3); pv_one<3>(o[3], vb, pa0, pa1, pa2, pa3);
}
__device__ __forceinline__ void attn_dense_body(const bf16_t* __restrict__ Qb, const bf16_t* __restrict__ Kh, const bf16_t* __restrict__ Vh, bf16_t* __restrict__ Ob, int seq, char* lds) {
  const int tid = otid(), wid = tid >> 6, lane = tid & 63, r32 = lane & 31, hi = lane >> 5;
  bf16_t* V_lds = (bf16_t*)lds; bf16_t* K_lds = (bf16_t*)(lds + 2 * SHM_V);
  float* ws = (float*)(lds + 2 * SHM_V + 2 * SHM_K) + wid * 64; float* li_l = ws; float* al_l = ws + 32;
  float m_reg = -1e30f, l_reg = 0; f32x16 o[4] = {}; bf16x8 qr[8];
  const bf16_t* Qw = Qb + (long)(wid * QBLK + r32) * LDQ + hi * 8;
#pragma unroll
  for (int d0 = 0; d0 < 8; ++d0) qr[d0] = *reinterpret_cast<const bf16x8*>(Qw + d0 * 16);
  const int sr = tid >> 4, sc = (tid & 15) * 8, vst0 = v_st(sr, sc), vst1 = v_st(32 + sr, sc);
  const int vb0 = (int)(uintptr_t)V_lds + v_rd_base(lane);
  struct { bf16x8 vs0, vs1, ks0, ks1; } sr_[2];
#define SLOAD(i, k0) do { sr_[i].vs0 = *reinterpret_cast<const bf16x8*>(&Vh[(long)((k0) + sr) * LDK + sc]); sr_[i].vs1 = *reinterpret_cast<const bf16x8*>(&Vh[(long)((k0) + 32 + sr) * LDK + sc]); \
    sr_[i].ks0 = *reinterpret_cast<const bf16x8*>(&Kh[(long)((k0) + sr) * LDK + sc]); sr_[i].ks1 = *reinterpret_cast<const bf16x8*>(&Kh[(long)((k0) + 32 + sr) * LDK + sc]); } while (0)
#define SWRITE(b, i) do { *(bf16x8*)((char*)V_lds + (b) * SHM_V + vst0) = sr_[i].vs0;          \
    *(bf16x8*)((char*)V_lds + (b) * SHM_V + vst1) = sr_[i].vs1; int kc = sc * 2;               \
    *(bf16x8*)((char*)K_lds + (b) * SHM_K + KSWZ(sr, kc)) = sr_[i].ks0;                       \
    *(bf16x8*)((char*)K_lds + (b) * SHM_K + KSWZ(32 + sr, kc)) = sr_[i].ks1; } while (0)
#define SWAIT() asm volatile("s_waitcnt vmcnt(4)" ::: "memory")
#define RESC(a) do { if (__any((a) < 1.f)) { if (hi == 0) al_l[r32] = (a); asm volatile("s_waitcnt lgkmcnt(0)" ::: "memory"); \
    _Pragma("unroll") for (int d = 0; d < 4; ++d) _Pragma("unroll") for (int r = 0; r < 16; ++r) o[d][r] *= al_l[crow(r, hi)]; } } while (0)
  f32x16 pA0, pA1, pB0, pB1; float mnA, mnB, alA, alB; bf16x8 pa0, pa1, pa2, pa3; const int NT = seq / KVBLK;
  constexpr int SE = 0, SO = 1;
  SLOAD(SE, 0); asm volatile("s_waitcnt vmcnt(0)" ::: "memory"); SWRITE(0, SE); __syncthreads();
  qkt(pA0, pA1, K_lds, qr, r32, hi); partialSM(pA0, pA1, m_reg, mnA, alA);
  SLOAD(SO, KVBLK); if (2 < NT) SLOAD(SE, 2 * KVBLK);
  SWAIT(); SWRITE(1, SO); __syncthreads();
  for (int j = 1; j + 1 < NT; j += 2) {
    SBAR(); qkt(pB0, pB1, (bf16_t*)((char*)K_lds + SHM_K), qr, r32, hi);
    finishSM(pA0, pA1, alA, l_reg, pa0, pa1, pa2, pa3); SBAR();
    SLOAD(SO, (j + 2) * KVBLK); SBAR();
    pv_d0(o, vb0, pa0, pa1, pa2, pa3); partialSM(pB0, pB1, m_reg, mnB, alB);
    __syncthreads(); SWAIT(); SWRITE(0, SE);
    RESC(alB); __syncthreads();
    SBAR(); qkt(pA0, pA1, K_lds, qr, r32, hi);
    finishSM(pB0, pB1, alB, l_reg, pa0, pa1, pa2, pa3); SBAR();
    if (j + 3 < NT) SLOAD(SE, (j + 3) * KVBLK); SBAR();
    pv_d0(o, vb0 + (int)SHM_V, pa0, pa1, pa2, pa3); partialSM(pA0, pA1, m_reg, mnA, alA);
    __syncthreads(); SWAIT(); SWRITE(1, SO);
    RESC(alA); __syncthreads();
  }
  SBAR(); qkt(pB0, pB1, (bf16_t*)((char*)K_lds + SHM_K), qr, r32, hi);
  finishSM(pA0, pA1, alA, l_reg, pa0, pa1, pa2, pa3); SBAR();
  pv_d0(o, vb0, pa0, pa1, pa2, pa3); partialSM(pB0, pB1, m_reg, mnB, alB);
  __syncthreads(); RESC(alB);
  finishSM(pB0, pB1, alB, l_reg, pa0, pa1, pa2, pa3); SBAR();
  pv_d0(o, vb0 + (int)SHM_V, pa0, pa1, pa2, pa3);
  if (hi == 0) li_l[r32] = l_reg; asm volatile("s_waitcnt lgkmcnt(0)" ::: "memory");
  float rli[16];
#pragma unroll
  for (int r = 0; r < 16; ++r) rli[r] = __builtin_amdgcn_rcpf(li_l[crow(r, hi)]);
  bf16_t* Ow = Ob + (long)(wid * QBLK) * LDO;
#pragma unroll
  for (int r = 0; r < 16; ++r) { int orow = crow(r, hi);
#pragma unroll
    for (int d0 = 0; d0 < 4; ++d0) { const unsigned pk = cvt_pk_bf16(o[d0][r] * rli[r], 0.f); Ow[(long)orow * LDO + d0 * 32 + r32] = (bf16_t)(pk & 0xffffu); } }
  __syncthreads();
#undef SLOAD
#undef SWRITE
#undef SWAIT
#undef RESC
}
}

__device__ __forceinline__ void attn_phase(const Params& P, unsigned char* lds_raw) {
    const bf16_t* QB = (const bf16_t*)(P.ws + WS_QB); const bf16_t* KB = (const bf16_t*)(P.ws + WS_KB); const bf16_t* VB = (const bf16_t*)(P.ws + WS_VB); bf16_t* OB = (bf16_t*)(P.ws + WS_OB);
    const int G = gridDim.x, c = obid();
    for (int u = c, r = 0; u < 512; u += G, ++r) {
        int qblk = u & 7, hq = (u >> 3) & 15, b = u >> 7;
        if (G == 256) {
            const int set = 8 * r + (c & 7), q = c >> 3; b = set >> 2; hq = (set & 3) * 4 + (q >> 3); qblk = q & 7;
        }
        const int kvh = hq >> 2;
        const size_t q0 = ((size_t)b * SEQ + qblk * 256) * DM + hq * 128, k0 = (size_t)b * TKV * KVD + kvh * 128;
        att::attn_dense_body(QB + q0, KB + k0, VB + k0, OB + q0, TKV, (char*)lds_raw);
    }
}

__global__ void __launch_bounds__(512, 2) fwd_kernel(Params P) {
    extern __shared__ __attribute__((aligned(16))) unsigned char lds[];
    cg::grid_group grid = cg::this_grid();
    unsigned char* ws = P.ws;
    float* H = (float*)(ws + WS_H); bf16_t* Abuf = (bf16_t*)(ws + WS_A); bf16_t* HID = (bf16_t*)(ws + WS_HID);
    const float* mod = (const float*)(ws + WS_MOD);
    const int G = gridDim.x;
    volatile LAS unsigned* stw = (volatile LAS unsigned*)((LAS unsigned char*)lds + LDS_MAIN);
    if (threadIdx.x < 4) stw[threadIdx.x] = 0u;
    __syncthreads();
    XcdBarrier xbar = xcd_barrier_post((unsigned*)(ws + WS_BAR), stw);
#ifdef EXTRA_SYNCS
    for (int i = 0; i < EXTRA_SYNCS; ++i) grid.sync();
#endif
#if PROBE_GROUP >= 0
    unsigned long long t_prev = __builtin_amdgcn_s_memrealtime(), t_sum = 0; int prev_kind = -1;
#endif
    int ph_first = P.ph_lo;
#ifdef RPH
    int rph_left = 1;
#endif
#pragma unroll 1
    for (int ph = P.ph_lo; ph < P.ph_hi; ++ph) {
        if (ph > ph_first) { if (P.ph_lo < 0) grid.sync(); else xcd_barrier(xbar); }
        int kind = 0, l = ph >= 13 ? 1 : 0, wi = 0, nmt = 0;
        switch (ph) {
            case 0: kind = 0; break;
            case 1: kind = 1; nmt = 0; break;   case 2: kind = 2; wi = 0; break;   case 3: kind = 3; wi = 0; break;   case 4: kind = 4; wi = 0; break;
            case 5: kind = 1; nmt = 1; break;   case 6: kind = 5; break;           case 7: kind = 6; break;           case 8: kind = 7; break;
            case 9: kind = 1; nmt = 2; break;   case 10: kind = 2; wi = 1; break;  case 11: kind = 3; wi = 1; break;  case 12: kind = 4; wi = 1; break;
            case 13: kind = 1; nmt = 0; break;  case 14: kind = 2; wi = 2; break;  case 15: kind = 3; wi = 2; break;  case 16: kind = 4; wi = 2; break;
            case 17: kind = 1; nmt = 1; break;  case 18: kind = 8; break;          case 19: kind = 9; break;          case 20: kind = 10; break;  case 21: kind = 11; break;
            case 22: kind = 1; nmt = 2; break;  case 23: kind = 12; wi = 3; break; default: kind = 4; wi = 3; break;
        }
        const bool legacy = (G != 256);
#if PROBE_GROUP >= 0
        { const unsigned long long t_now = __builtin_amdgcn_s_memrealtime();
          const int grp = prev_kind == 0 ? 0 : (prev_kind == 2 || prev_kind == 3 || prev_kind == 4 || prev_kind == 7 || prev_kind == 8 || prev_kind == 11 || prev_kind == 12) ? 1 : prev_kind == 5 ? 2 : prev_kind == 10 ? 3 : prev_kind == 1 ? 4 : 5;
          if (prev_kind >= 0 && grp == PROBE_GROUP) t_sum += t_now - t_prev;
          t_prev = t_now; prev_kind = kind; }
#endif
        const float* modl = mod + (size_t)l * 5 * NMODC;
        if (kind == 0) { p0_phase(P, lds); }
        else if (kind == 1) {
            const float* sl = H; const float* sx = H + (size_t)MLAT * DM; int nrows = MTOT; const float* gn; int chs, chc;
            if (ph == 1) { sl = P.in[0]; sx = P.in[2]; }
            if (ph == 22) nrows = MLAT;
            if (nmt == 0) { gn = P.in[6] + l * DM; chs = 0; chc = 1; }
            else if (nmt == 1) { gn = P.in[7] + l * DM; chs = 3; chc = 4; }
            else { gn = P.in[8] + l * DM; chs = 6; chc = 7; }
            normmod_phase(sl, sx, nrows, gn, modl, chs, chc, Abuf);
        }
        else if (kind == 5) { s5_phase(P, lds); }
        else if (kind == 6) { s5_merge_phase(P); }
        else if (kind == 9) { qknorm_phase(P); }
        else if (kind == 10) { attn_phase(P, lds); }
        else {
            const int cp = (obid() & 7) * 32 + (obid() >> 3);
            const int ncalls = (kind == 3 && !legacy && cp >= 224) ? 2 : 1;
#pragma unroll 1
            for (int call = 0; call < ncalls; ++call) {
                pg8::Gemm g; pg8::EpiAny E; pg8::StaticOrder S;
                E.sw = pg8::EpiSwiglu{HID, DFF};
                E.rs.res_lat = H; E.rs.res_ctx = H + (size_t)MLAT * DM; E.rs.out_lat = H; E.rs.out_ctx = H + (size_t)MLAT * DM; E.rs.coef = 0.5f;
                E.rs.gate = modl + (size_t)((wi & 1) ? 8 : 2) * DM;
                if (wi == 0) { E.rs.res_lat = P.in[0]; E.rs.res_ctx = P.in[2]; }
                if (wi == 3) { E.rs.out_lat = P.out; E.rs.out_ctx = P.out; }
                E.gl = pg8::EpiGlu{H, modl + (size_t)5 * DM};
                E.f3 = pg8::EpiF32{(float*)(ws + WS_QKV), NQKV, (bf16_t*)(ws + WS_VB)};
                const bf16_t* Wgu = (const bf16_t*)(ws + WS_WGU + (size_t)wi * SZ_WGU); const bf16_t* Wd = (const bf16_t*)(ws + WS_WD + (size_t)wi * SZ_WD);
                if (kind == 2 || kind == 12 || (kind == 3 && call == 0)) {
                    const int M = (kind == 12) ? MLAT : MTOT;
                    g = pg8::Gemm{Abuf, Wgu, M, 2 * DFF, DM}; E.mode = 0; S.init(M, 2 * DFF, G, obid());
                    if (kind == 2 && !legacy) S.mode = 1;
                    if (kind == 3) S.mode = legacy ? 4 : 2;
                } else if (kind == 3) {
                    g = pg8::Gemm{HID, Wd, MTOT, DM, DFF}; E.mode = 1; S.init(MTOT, DM, G, obid()); S.mode = 3; S.spm = 32 + ((cp - 224) & 3); S.spn = (cp - 224) >> 2;
                } else if (kind == 4) {
                    const int M = (legacy && wi != 3) ? MTOT : MLAT;
                    g = pg8::Gemm{HID, Wd, M, DM, DFF}; E.mode = 1; S.init(M, DM, G, obid());
                } else if (kind == 7) {
                    g = pg8::Gemm{(const bf16_t*)(ws + WS_Z), (const bf16_t*)(ws + WS_W12), MTOT, 4096, DM}; E.mode = 2; S.init(MTOT, 4096, G, obid());
                } else if (kind == 8) {
                    g = pg8::Gemm{Abuf, (const bf16_t*)(ws + WS_WQKV), MTOT, NQKV, DM}; E.mode = 3; S.init(MTOT, NQKV, G, obid());
                } else {
                    g = pg8::Gemm{(const bf16_t*)(ws + WS_OB), (const bf16_t*)(ws + WS_WO), MLAT, DM, DM}; E.mode = 1; E.rs.coef = 1.f; E.rs.gate = modl + (size_t)5 * DM; S.init(MLAT, DM, G, obid());
                    E.rs.res_lat = H; E.rs.out_lat = H;
                }
                pg8::gemm_phase((LAS unsigned char*)lds, g, S, E, E.mode == 0);
            }
            if (!legacy) {
                if (kind == 3 && cp >= 112 && cp < 224) { const int r = cp - 112;
                    if (wi == 0) convert_range(P, 0, r * TAIL_UB, r * TAIL_UB + TAIL_UB);
                    else { const int base = wi == 1 ? 1536 : 2656, lo = base + r * TAIL_UB, hi = lo + TAIL_UB; convert_range(P, 1, lo, hi); } }
                if (kind == 7 && obid() >= 64) { const int r = obid() - 64; convert_range(P, 1, r * TAIL_GLU, r * TAIL_GLU + TAIL_GLU); }
                if (kind == 8 && obid() >= 176) { const int r = obid() - 176; convert_range(P, 1, 3776 + r * TAIL_QKV, 3776 + r * TAIL_QKV + TAIL_QKV); }
            }
        }
#ifdef RPH
        if (ph == RPH && rph_left > 0) { --rph_left; --ph; ph_first = -1; }
#endif
    }
#if PROBE_GROUP >= 0
    grid.sync();
    { const unsigned long long t_now = __builtin_amdgcn_s_memrealtime();
      const int grp = 1;
      if (grp == PROBE_GROUP) t_sum += t_now - t_prev;
      if (blockIdx.x == 0) {
          float* sh = (float*)lds;
          if (threadIdx.x == 0) sh[0] = 1e-3f * sqrtf((float)t_sum * 0.01f);
          __syncthreads();
          const float dl = sh[0];
          for (int i = threadIdx.x; i < 4096; i += 512) P.out[i] += dl;
      } }
#endif
}

extern "C" void kernel_launch(void* const* d_in, const int* in_sizes, int n_in, void* d_out, int out_size, void* d_ws, size_t ws_size, hipStream_t stream) {
    static int grid = 0;
    if (grid == 0) {
        if (n_in != 29 || ws_size < WS_END) { fprintf(stderr, "kernel_launch: unexpected n_in %d or ws_size %zu (< %zu)\n", n_in, ws_size, (size_t)WS_END); grid = -1; return; }
        int dev = 0, cus = 0, per_cu = 0;
        hipGetDevice(&dev);
        hipDeviceGetAttribute(&cus, hipDeviceAttributeMultiprocessorCount, dev);
        if (hipFuncSetAttribute((const void*)fwd_kernel, hipFuncAttributeMaxDynamicSharedMemorySize, LDS_BYTES) != hipSuccess) { fprintf(stderr, "kernel_launch: hipFuncSetAttribute failed\n"); grid = -1; return; }
        if (hipOccupancyMaxActiveBlocksPerMultiprocessor(&per_cu, (const void*)fwd_kernel, 512, LDS_BYTES) != hipSuccess || per_cu < 1) { fprintf(stderr, "kernel_launch: occupancy query says %d\n", per_cu); per_cu = 1; }
        (void)hipGetLastError();
        grid = cus * 1;
    }
    if (grid < 0) return;
    if (hipMemsetAsync((char*)d_ws + WS_BAR, 0, 16384, stream) != hipSuccess) { fprintf(stderr, "kernel_launch: memset failed\n"); return; }
    Params p{};
    for (int i = 0; i < 29; ++i) p.in[i] = (const float*)d_in[i];
    p.out = (float*)d_out; p.ws = (unsigned char*)d_ws;
#if MULTI_LAUNCH
    for (int ph = 0; ph < NPHASE; ++ph) {
        p.ph_lo = ph; p.ph_hi = ph + 1;
        hipLaunchKernelGGL(fwd_kernel, dim3(grid), dim3(512), LDS_BYTES, stream, p);
    }
#else
    p.ph_lo = 0; p.ph_hi = NPHASE;
    void* args[] = {&p};
    hipError_t e = hipLaunchCooperativeKernel((const void*)fwd_kernel, dim3(grid), dim3(512), args, LDS_BYTES, stream);
    if (e != hipSuccess) fprintf(stderr, "cooperative launch failed: %s (grid %d)\n", hipGetErrorString(e), grid);
#endif
}
```
